# Optimizing an MI355X kernel written in HIP

```python
import jax, jax.numpy as jnp
from jax import lax
import numpy as np

D_MODEL = 1024
BATCH = 16
SEQ = 2048
DEPTH = 2
DEC_BATCH = 4
DEC_SEQ = 4096
PAST_LEN = 128

D_MIX = D_MODEL
CHUNK = 128
A_HEADS = 4
A_WIDTH = 3 * D_MIX // 8
A_HEAD_DIM = A_WIDTH // A_HEADS
POOL_WINDOWS = (2, 4, 8, 16)
B_GROUPS = len(POOL_WINDOWS)
B_WIDTH = 3 * D_MIX // 8
B_GROUP_DIM = B_WIDTH // B_GROUPS
C_GROUPS = 4
C_WIDTH = D_MIX - A_WIDTH - B_WIDTH
C_GROUP_DIM = C_WIDTH // C_GROUPS
SPLIT_WIDTHS = (A_WIDTH, A_WIDTH, A_WIDTH, B_WIDTH, B_WIDTH, C_WIDTH, C_WIDTH)
IN_WIDTH = sum(SPLIT_WIDTHS)
EPS = 1e-6

kernel_name = "hybrid_sgu_pool_fourier_encoder"


def rms_norm(x, g):
    xf = x.astype(jnp.float32)
    y = xf * lax.rsqrt(jnp.mean(xf * xf, axis=-1, keepdims=True) + EPS)
    return (y * g.astype(jnp.float32)).astype(x.dtype)


def layer_norm(x, g, b):
    xf = x.astype(jnp.float32)
    mu = jnp.mean(xf, axis=-1, keepdims=True)
    var = jnp.mean(jnp.square(xf - mu), axis=-1, keepdims=True)
    y = (xf - mu) * lax.rsqrt(var + EPS)
    return (y * g.astype(jnp.float32) + b.astype(jnp.float32)).astype(x.dtype)


def mixer_a(u, v, ln_g, ln_b, w_s, b_s):
    bsz, s, _ = u.shape
    u = jax.nn.gelu(u)
    v = jax.nn.gelu(v).reshape(bsz, s // CHUNK, CHUNK, A_HEADS, A_HEAD_DIM)
    v = layer_norm(v, ln_g.reshape(A_HEADS, A_HEAD_DIM), ln_b.reshape(A_HEADS, A_HEAD_DIM))
    mixed = jnp.einsum('hpq,bcqhd->bcphd', w_s, v) + b_s.T[None, None, :, :, None]
    return u * mixed.reshape(bsz, s, A_WIDTH)


def mixer_b(z, w_b, scale_b):
    bsz, s, _ = z.shape
    zf = z.astype(jnp.float32)
    csum = jnp.concatenate([jnp.zeros((bsz, 1, B_WIDTH), jnp.float32), lax.cumsum(zf, axis=1)], axis=1)
    pos = jnp.arange(s, dtype=jnp.int32)
    outs = []
    for g, w in enumerate(POOL_WINDOWS):
        lo = jnp.clip(pos - w // 2, 0, s)
        hi = jnp.clip(pos + w // 2, 0, s)
        sl = slice(g * B_GROUP_DIM, (g + 1) * B_GROUP_DIM)
        cs = csum[..., sl]
        mean = (cs[:, hi] - cs[:, lo]) / (hi - lo).astype(jnp.float32)[None, :, None]
        outs.append(mean - zf[..., sl])
    pooled = jnp.concatenate(outs, axis=-1).astype(z.dtype).reshape(bsz, s, B_GROUPS, B_GROUP_DIM)
    y = jnp.einsum('bsgc,gcd->bsgd', pooled, w_b).reshape(bsz, s, B_WIDTH)
    return y * scale_b


def mixer_c(z, w_c):
    bsz, s, _ = z.shape
    zg = z.astype(jnp.float32).reshape(bsz, s, C_GROUPS, C_GROUP_DIM)
    f = jnp.fft.fft2(zg, axes=(1, 3), norm="ortho").real.astype(z.dtype)
    return jnp.einsum('bsgc,gcd->bsgd', f, w_c).reshape(bsz, s, C_WIDTH)


def encoder_layer(x, pre_g, w_in, a_ln_g, a_ln_b, a_w_s, a_b_s, b_w, b_scale, c_w, w_out, post_g):
    h = rms_norm(x, pre_g)
    proj = jnp.einsum('bsd,de->bse', h, w_in)
    offsets = list(np.cumsum(SPLIT_WIDTHS)[:-1])
    a_u, a_v, a_gate, b_in, b_gate, c_in, c_gate = jnp.split(proj, offsets, axis=-1)
    ya = mixer_a(a_u, a_v, a_ln_g, a_ln_b, a_w_s, a_b_s) * jax.nn.silu(a_gate)
    yb = mixer_b(b_in, b_w, b_scale) * jax.nn.silu(b_gate)
    yc = mixer_c(c_in, c_w) * jax.nn.silu(c_gate)
    y = jnp.einsum('bse,ed->bsd', jnp.concatenate([ya, yb, yc], axis=-1), w_out)
    return x + rms_norm(y, post_g)


def trunk(x, pre_norm_g, w_in, a_ln_g, a_ln_b, a_w_s, a_b_s, b_w, b_scale, c_w, w_out, post_norm_g):
    for l in range(DEPTH):
        x = encoder_layer(x, pre_norm_g[l], w_in[l], a_ln_g[l], a_ln_b[l], a_w_s[l], a_b_s[l],
                          b_w[l], b_scale[l], c_w[l], w_out[l], post_norm_g[l])
    return x


def setup_inputs(seed: int = 0) -> dict:
    key = jax.random.key(seed)
    ks = jax.random.split(key, 14)
    f32 = jnp.float32
    nrm = lambda k, shape, s: (jax.random.normal(k, shape, f32) * s)
    return {
        "x_prompt": nrm(ks[0], (BATCH, SEQ, D_MODEL), 1.0),
        "x_sample": nrm(ks[1], (DEC_BATCH, DEC_SEQ, D_MODEL), 1.0),
        "pre_norm_g": 1.0 + nrm(ks[2], (DEPTH, D_MODEL), 0.05),
        "w_in": nrm(ks[3], (DEPTH, D_MODEL, IN_WIDTH), D_MODEL ** -0.5),
        "a_ln_g": 1.0 + nrm(ks[4], (DEPTH, A_WIDTH), 0.05),
        "a_ln_b": nrm(ks[5], (DEPTH, A_WIDTH), 0.02),
        "a_w_s": nrm(ks[6], (DEPTH, A_HEADS, CHUNK, CHUNK), CHUNK ** -0.5),
        "a_b_s": 1.0 + nrm(ks[7], (DEPTH, A_HEADS, CHUNK), 0.1),
        "b_w": nrm(ks[8], (DEPTH, B_GROUPS, B_GROUP_DIM, B_GROUP_DIM), B_GROUP_DIM ** -0.5),
        "b_scale": 1.0 + nrm(ks[9], (DEPTH, B_WIDTH), 0.1),
        "c_w": nrm(ks[10], (DEPTH, C_GROUPS, C_GROUP_DIM, C_GROUP_DIM), C_GROUP_DIM ** -0.5),
        "w_out": nrm(ks[11], (DEPTH, D_MIX, D_MODEL), D_MIX ** -0.5),
        "post_norm_g": 1.0 + nrm(ks[12], (DEPTH, D_MODEL), 0.05),
    }


def reference(x_prompt, x_sample, pre_norm_g, w_in, a_ln_g, a_ln_b, a_w_s, a_b_s, b_w, b_scale, c_w, w_out, post_norm_g):
    y_prompt = trunk(x_prompt, pre_norm_g, w_in, a_ln_g, a_ln_b, a_w_s, a_b_s, b_w, b_scale, c_w, w_out, post_norm_g)
    y_sample = trunk(x_sample, pre_norm_g, w_in, a_ln_g, a_ln_b, a_w_s, a_b_s, b_w, b_scale, c_w, w_out, post_norm_g)
    return (y_prompt, y_sample)
```

```cpp
#include <hip/hip_runtime.h>
#include <hip/hip_cooperative_groups.h>
#include <cstdio>
#include <cstdint>
namespace cg = cooperative_groups;

#ifndef N_LAUNCH_MODE
#define N_LAUNCH_MODE 0
#endif

#define LAS __attribute__((address_space(3)))
typedef unsigned short bf16_t;
typedef short bf16x8 __attribute__((ext_vector_type(8)));
typedef float f32x4 __attribute__((ext_vector_type(4)));
typedef float f32x2 __attribute__((ext_vector_type(2)));
typedef unsigned u32x4 __attribute__((ext_vector_type(4)));
typedef unsigned u32x2 __attribute__((ext_vector_type(2)));

constexpr int T_TOK = 49152, TP = 32768, DM = 1024, INW = 2432;
constexpr int LDP = 2688;
constexpr int N1PAD = 2816;
constexpr int C_U = 0, C_V = 384, C_AG = 768, C_BG = 1152, C_CG = 1536, C_B = 1792, C_PC = 2176, C_PS = 2432;
constexpr float EPS = 1e-6f;
constexpr size_t OFF_W1T = 0;
constexpr size_t OFF_WOT = OFF_W1T + (size_t)2 * N1PAD * 1024 * 2;
constexpr size_t OFF_WSB = OFF_WOT + (size_t)2 * 1024 * 1024 * 2;
constexpr size_t OFF_DQ = OFF_WSB + (size_t)2 * 4 * 128 * 128 * 2;
constexpr size_t OFF_BAR = OFF_DQ + (size_t)256 * 512 * 2;
constexpr size_t OFF_XB = OFF_BAR + 16384;
constexpr size_t OFF_PROJ = OFF_XB + (size_t)T_TOK * 1024 * 2;
constexpr size_t OFF_YM = OFF_PROJ + (size_t)T_TOK * LDP * 2;
constexpr size_t WS_END = OFF_YM + (size_t)T_TOK * 1024 * 2;
constexpr int LDS_BYTES = 131072;

struct Args {
    const float* in[13];
    float* out;
    unsigned char* ws;
    int ph_lo, ph_hi;
};

__device__ __forceinline__ unsigned cvt_pk_bf16(float lo, float hi) { unsigned r; asm volatile("v_cvt_pk_bf16_f32 %0, %1, %2" : "=v"(r) : "v"(lo), "v"(hi)); return r; }
__device__ __forceinline__ float bf_lo(unsigned w) { return __uint_as_float(w << 16); }
__device__ __forceinline__ float bf_hi(unsigned w) { return __uint_as_float(w & 0xffff0000u); }
__device__ __forceinline__ float wave_sum(float v) {
#pragma unroll
    for (int o = 1; o < 64; o <<= 1) v += __shfl_xor(v, o);
    return v;
}
__device__ __forceinline__ float sigmoid_fast(float z) { return __builtin_amdgcn_rcpf(1.0f + __builtin_amdgcn_exp2f(-1.4426950409f * z)); }
__device__ __forceinline__ float gelu_tanh(float x) { const float z = 1.5957691216f * (x + 0.044715f * x * x * x); return x * sigmoid_fast(z); }
__device__ __forceinline__ float silu_f(float x) { return x * sigmoid_fast(x); }

__device__ __forceinline__ int opaque_tid() { int t = threadIdx.x; asm volatile("" : "+v"(t)); return t; }
namespace pg8 {
constexpr int BM = 256, BK = 64, HALF = 128, HTB = HALF * BK * 2, STAGE_BYTES = 8 * HTB, NXCD = 8, WGM = 8;
__host__ __device__ __forceinline__ int lds_byte(int r, int c) { const int st = (r >> 4) * 2 + (c >> 5), rr = r & 15, cc = c & 31, ob = rr * 64 + cc * 2; return st * 1024 + (ob ^ (((ob >> 9) & 1) << 5)); }
__host__ __device__ __forceinline__ void stage_rc(int b, int& R, int& C) { const int st = b / 1024, sb = b % 1024, swz = sb ^ (((sb >> 9) & 1) << 5); R = (st >> 1) * 16 + swz / 64; C = (st & 1) * 32 + (swz % 64) / 2; }
__host__ __device__ __forceinline__ int perm32(int rho) { const int n = rho >> 4, i = rho & 15; return 8 * (i >> 2) + 4 * n + (i & 3); }
struct Unit { int pm, pn; };
struct Gemm { const bf16_t* A; const bf16_t* Bt; int M, N, K; };
struct StaticOrder {
    int nM, nN, nwg, G, c;
    __device__ void init(int M, int N, int G_, int c_) { nM = M / BM; nN = N / BM; nwg = nM * nN; G = G_; c = c_; }
    __device__ bool next(int i, Unit& u) const {
        const long L = (long)i * G + c; if (L >= nwg) return false;
        int wgid = (int)L; { const int q = nwg / NXCD, r = nwg % NXCD, xcd = wgid % NXCD, off = wgid / NXCD; wgid = (xcd < r ? xcd * (q + 1) : r * (q + 1) + (xcd - r) * q) + off; }
        const int nig = WGM * nN, gid = wgid / nig, fm = gid * WGM, gsz = (nM - fm) < WGM ? (nM - fm) : WGM;
        u.pm = fm + ((wgid % nig) % gsz); u.pn = (wgid % nig) / gsz; return true;
    }
};
template <class Epi>
__device__ __forceinline__ void gemm_phase(LAS unsigned char* lds, const Gemm g, const StaticOrder& S, const Epi& E) {
    const int tid = opaque_tid(), wid = __builtin_amdgcn_readfirstlane(tid >> 6), lane = tid & 63, wr = wid >> 2, wc = wid & 3, fr = lane & 15, fq = lane >> 4;
    const int K = g.K, nt = K / BK;
    unsigned voffA[2], voffB[2];
#pragma unroll
    for (int i = 0; i < 2; ++i) { int R, C; stage_rc(tid * 16 + i * 8192, R, C); const int Rb = (R & ~31) + perm32(R & 31);
        voffA[i] = (unsigned)(R * K + C) * 2u; voffB[i] = (unsigned)(Rb * K + C) * 2u; }
    const size_t kstep = (size_t)(BK * 2);
    const size_t hstep = (size_t)HALF * K * 2;
    const size_t tstep = 2 * hstep;
    const unsigned ldsw = (unsigned)wid * 1024u;
    const int aoff = lds_byte(wr * 64 + fr, fq * 8), boff = lds_byte(wc * 32 + fr, fq * 8);
#define PG8_SA(b, h) (((b) * 2 + (h)) * HTB)
#define PG8_SB(b, h) ((4 + (b) * 2 + (h)) * HTB)
#define PG8_STAGE(bufoff, gbase, voff) do { _Pragma("unroll") for (int _i = 0; _i < 2; ++_i) \
        __builtin_amdgcn_global_load_lds((const unsigned*)((const char*)(gbase) + (voff)[_i]), (LAS unsigned*)(lds + (bufoff) + ldsw + _i * 8192), 16, 0, 0); } while (0)
#define PG8_LDA(dst, b, h) do { _Pragma("unroll") for (int m = 0; m < 4; ++m) _Pragma("unroll") for (int k = 0; k < 2; ++k) dst[m][k] = *(const LAS bf16x8*)(lds + PG8_SA(b, h) + aoff + m * 2048 + k * 1024); } while (0)
#define PG8_LDB(dst, b, h) do { _Pragma("unroll") for (int n = 0; n < 2; ++n) _Pragma("unroll") for (int k = 0; k < 2; ++k) dst[n][k] = *(const LAS bf16x8*)(lds + PG8_SB(b, h) + boff + n * 2048 + k * 1024); } while (0)
#define PG8_MMA(ai, bj, At, Bt) do { __builtin_amdgcn_s_setprio(1); _Pragma("unroll") for (int m = 0; m < 4; ++m) _Pragma("unroll") for (int n = 0; n < 2; ++n) _Pragma("unroll") for (int k = 0; k < 2; ++k) \
        acc[ai][bj][m][n] = __builtin_amdgcn_mfma_f32_16x16x32_bf16(Bt[n][k], At[m][k], acc[ai][bj][m][n], 0, 0, 0); __builtin_amdgcn_s_setprio(0); } while (0)
#define PG8_WAIT_V(n) asm volatile("s_waitcnt vmcnt(" #n ")" ::: "memory")
#define PG8_WAIT_L(n) asm volatile("s_waitcnt lgkmcnt(" #n ")" ::: "memory")
#define PG8_BAR __builtin_amdgcn_s_barrier()
#define PG8_SCHED __builtin_amdgcn_sched_barrier(0)
    Unit cur, nxt; int ui = 0;
    if (!S.next(0, cur)) return;
    f32x4 acc[2][2][4][2];
#pragma unroll
    for (int a = 0; a < 2; ++a)
#pragma unroll
        for (int b = 0; b < 2; ++b)
#pragma unroll
            for (int m = 0; m < 4; ++m)
#pragma unroll
                for (int n = 0; n < 2; ++n) acc[a][b][m][n] = (f32x4){0.f, 0.f, 0.f, 0.f};
    bf16x8 At[4][2], B0[2][2], B1[2][2];
    const char* cA = (const char*)g.A + (size_t)cur.pm * tstep; const char* cB = (const char*)g.Bt + (size_t)cur.pn * tstep;
    PG8_STAGE(PG8_SB(0, 0), cB, voffB); PG8_STAGE(PG8_SA(0, 0), cA, voffA); PG8_STAGE(PG8_SB(0, 1), cB + hstep, voffB); PG8_STAGE(PG8_SA(0, 1), cA + hstep, voffA);
    if (wr == 1) PG8_BAR;
    PG8_WAIT_V(4); PG8_BAR;
    PG8_STAGE(PG8_SB(1, 0), cB + kstep, voffB); PG8_STAGE(PG8_SA(1, 0), cA + kstep, voffA); PG8_STAGE(PG8_SB(1, 1), cB + hstep + kstep, voffB);
    PG8_WAIT_V(6); PG8_BAR;
    for (;;) {
        const bool has_next = S.next(ui + 1, nxt);
        const char* nA = has_next ? (const char*)g.A + (size_t)nxt.pm * tstep : cA; const char* nB = has_next ? (const char*)g.Bt + (size_t)nxt.pn * tstep : cB;
        for (int t = 0; t < nt; t += 2) {
            const bool last = (t == nt - 2);
            const char* a1 = cA + (size_t)(t + 1) * kstep;
            const char* a2 = last ? nA : cA + (size_t)(t + 2) * kstep; const char* b2 = last ? nB : cB + (size_t)(t + 2) * kstep;
            const char* a3 = a2 + kstep; const char* b3 = b2 + kstep;
            PG8_LDB(B0, 0, 0); PG8_SCHED; PG8_LDA(At, 0, 0); PG8_STAGE(PG8_SA(1, 1), a1 + hstep, voffA);
            PG8_WAIT_L(8); PG8_BAR; PG8_WAIT_L(0); PG8_MMA(0, 0, At, B0); PG8_BAR; PG8_SCHED;
            PG8_LDB(B1, 0, 1); PG8_STAGE(PG8_SB(0, 0), b2, voffB);
            PG8_BAR; PG8_WAIT_L(0); PG8_MMA(0, 1, At, B1); PG8_BAR;
            PG8_LDA(At, 0, 1); PG8_STAGE(PG8_SA(0, 0), a2, voffA);
            PG8_BAR; PG8_WAIT_L(0); PG8_MMA(1, 0, At, B0); PG8_BAR; PG8_SCHED;
            PG8_STAGE(PG8_SB(0, 1), b2 + hstep, voffB);
            PG8_WAIT_V(6); PG8_BAR; PG8_MMA(1, 1, At, B1); PG8_BAR;
            PG8_LDB(B0, 1, 0); PG8_SCHED; PG8_LDA(At, 1, 0); PG8_STAGE(PG8_SA(0, 1), a2 + hstep, voffA);
            PG8_WAIT_L(8); PG8_BAR; PG8_WAIT_L(0); PG8_MMA(0, 0, At, B0); PG8_BAR; PG8_SCHED;
            PG8_LDB(B1, 1, 1); PG8_STAGE(PG8_SB(1, 0), b3, voffB);
            PG8_BAR; PG8_WAIT_L(0); PG8_MMA(0, 1, At, B1); PG8_BAR;
            PG8_LDA(At, 1, 1); PG8_STAGE(PG8_SA(1, 0), a3, voffA);
            PG8_BAR; PG8_WAIT_L(0); PG8_MMA(1, 0, At, B0); PG8_BAR; PG8_SCHED;
            PG8_STAGE(PG8_SB(1, 1), b3 + hstep, voffB);
            PG8_WAIT_V(6); PG8_BAR; PG8_MMA(1, 1, At, B1); PG8_BAR;
        }
        E(acc, cur, wr, wc, fr, fq);
        if (!has_next) break;
#pragma unroll
        for (int a = 0; a < 2; ++a)
#pragma unroll
            for (int b = 0; b < 2; ++b)
#pragma unroll
                for (int m = 0; m < 4; ++m)
#pragma unroll
                    for (int n = 0; n < 2; ++n) acc[a][b][m][n] = (f32x4){0.f, 0.f, 0.f, 0.f};
        cur = nxt; cA = nA; cB = nB; ++ui;
    }
    PG8_WAIT_V(0);
    if (wr == 0) PG8_BAR;
    PG8_BAR;
#undef PG8_SA
#undef PG8_SB
#undef PG8_STAGE
#undef PG8_LDA
#undef PG8_LDB
#undef PG8_MMA
#undef PG8_WAIT_V
#undef PG8_WAIT_L
#undef PG8_BAR
#undef PG8_SCHED
}
}
using pg8::Unit;

template <int ACT> __device__ __forceinline__ float act_f(float x) { if (ACT == 0) return gelu_tanh(x); if (ACT == 1) return silu_f(x); return x; }

struct EpiProj {
    bf16_t* O;
    template <int ACT> __device__ __forceinline__ void body(const f32x4 (&acc)[2][2][4][2], const Unit& u, int wr, int wc, int fr, int fq) const {
        const int row0 = u.pm * 256 + wr * 64 + fr, col0 = u.pn * 256 + wc * 32 + 8 * fq;
        const int nbj = (u.pn == 10) ? 1 : 2;
#pragma unroll
        for (int ai = 0; ai < 2; ++ai)
#pragma unroll
            for (int m = 0; m < 4; ++m) { bf16_t* rowp = O + (size_t)(row0 + ai * 128 + m * 16) * LDP + col0;
#pragma unroll
                for (int bj = 0; bj < 2; ++bj) { if (bj < nbj) { const f32x4 v0 = acc[ai][bj][m][0], v1 = acc[ai][bj][m][1];
                    u32x4 w; w.x = cvt_pk_bf16(act_f<ACT>(v0[0]), act_f<ACT>(v0[1])); w.y = cvt_pk_bf16(act_f<ACT>(v0[2]), act_f<ACT>(v0[3]));
                    w.z = cvt_pk_bf16(act_f<ACT>(v1[0]), act_f<ACT>(v1[1])); w.w = cvt_pk_bf16(act_f<ACT>(v1[2]), act_f<ACT>(v1[3]));
                    *(u32x4*)(rowp + bj * 128) = w; } } }
    }
    __device__ __forceinline__ void operator()(const f32x4 (&acc)[2][2][4][2], const Unit& u, int wr, int wc, int fr, int fq) const {
        if (u.pn < 3) body<0>(acc, u, wr, wc, fr, fq); else if (u.pn < 7) body<1>(acc, u, wr, wc, fr, fq); else body<2>(acc, u, wr, wc, fr, fq);
    }
};
struct EpiY {
    bf16_t* O;
    __device__ __forceinline__ void operator()(const f32x4 (&acc)[2][2][4][2], const Unit& u, int wr, int wc, int fr, int fq) const {
        const int row0 = u.pm * 256 + wr * 64 + fr, col0 = u.pn * 256 + wc * 32 + 8 * fq;
#pragma unroll
        for (int ai = 0; ai < 2; ++ai)
#pragma unroll
            for (int m = 0; m < 4; ++m) { bf16_t* rowp = O + (size_t)(row0 + ai * 128 + m * 16) * 1024 + col0;
#pragma unroll
                for (int bj = 0; bj < 2; ++bj) { const f32x4 v0 = acc[ai][bj][m][0], v1 = acc[ai][bj][m][1];
                    u32x4 w; w.x = cvt_pk_bf16(v0[0], v0[1]); w.y = cvt_pk_bf16(v0[2], v0[3]); w.z = cvt_pk_bf16(v1[0], v1[1]); w.w = cvt_pk_bf16(v1[2], v1[3]);
                    *(u32x4*)(rowp + bj * 128) = w; } }
    }
};
struct EpiDft {
    const bf16_t* P; bf16_t* Y;
    __device__ __forceinline__ void operator()(const f32x4 (&acc)[2][2][4][2], const Unit& u, int wr, int wc, int fr, int fq) const {
        const int j = u.pn; int tokbase, k1, R;
        if (j < 128) { tokbase = (j >> 3) * 2048; k1 = j & 7; R = 8; } else { const int jj = j - 128; tokbase = TP + (jj >> 4) * 4096; k1 = jj & 15; R = 16; }
        const int ch0 = wc * 32 + 8 * fq;
#pragma unroll
        for (int ai = 0; ai < 2; ++ai)
#pragma unroll
            for (int m = 0; m < 4; ++m) { const int k2 = ai * 128 + wr * 64 + m * 16 + fr; const size_t tok = (size_t)(tokbase + k1 + R * k2);
#pragma unroll
                for (int bj = 0; bj < 2; ++bj) { const int ch = ch0 + bj * 128;
                    const u32x4 gt = *(const u32x4*)(P + tok * LDP + C_CG + ch);
                    const f32x4 v0 = acc[ai][bj][m][0], v1 = acc[ai][bj][m][1];
                    u32x4 w; w.x = cvt_pk_bf16(v0[0] * bf_lo(gt.x), v0[1] * bf_hi(gt.x)); w.y = cvt_pk_bf16(v0[2] * bf_lo(gt.y), v0[3] * bf_hi(gt.y));
                    w.z = cvt_pk_bf16(v1[0] * bf_lo(gt.z), v1[1] * bf_hi(gt.z)); w.w = cvt_pk_bf16(v1[2] * bf_lo(gt.w), v1[3] * bf_hi(gt.w));
                    *(u32x4*)(Y + tok * 1024 + 768 + ch) = w; } }
    }
};

struct Ctx {
    const float *xp, *xs, *pre_g, *w_in, *a_ln_g, *a_ln_b, *a_w_s, *a_b_s, *b_w, *b_scale, *c_w, *w_out, *post_g;
    float* out;
    bf16_t *W1T, *WOT, *WSB, *DQ, *XB, *APT, *PROJ, *YO, *YM;
};

__device__ __forceinline__ void transpose_item(const float* W, int ldn, int col0, const float* ks, bf16_t* WT, int row0, int k0, LAS float* scr, int lane) {
#pragma unroll 8
    for (int i = 0; i < 32; ++i) { const int kk = 2 * i + (lane >> 5); float v = W[(size_t)(k0 + kk) * ldn + col0 + (lane & 31)]; if (ks) v *= ks[k0 + kk]; scr[kk * 33 + (lane & 31)] = v; }
    asm volatile("s_waitcnt lgkmcnt(0)" ::: "memory");
    const int c = lane & 7;
#pragma unroll
    for (int j = 0; j < 4; ++j) { const int n = (lane >> 3) + 8 * j; const LAS float* s = scr + (8 * c) * 33 + n;
        u32x4 o; o.x = cvt_pk_bf16(s[0 * 33], s[1 * 33]); o.y = cvt_pk_bf16(s[2 * 33], s[3 * 33]); o.z = cvt_pk_bf16(s[4 * 33], s[5 * 33]); o.w = cvt_pk_bf16(s[6 * 33], s[7 * 33]);
        *(u32x4*)(WT + (size_t)(row0 + n) * 1024 + k0 + 8 * c) = o; }
    asm volatile("s_waitcnt lgkmcnt(0)" ::: "memory");
}

template <int GD, int NP>
__device__ __forceinline__ void fold_compute(const Ctx& C, int l, int k0, int srccol, LAS float* Gm  , LAS float* Ws  , int dst0, int dst1) {
    constexpr int GS = NP + 4, J = NP / 8;
    const int tid = opaque_tid();
    for (int idx = tid; idx < 64 * GD; idx += 512) { const int kk = idx / GD, c = idx - kk * GD;
        Ws[kk * (GD + 1) + c] = C.w_in[(size_t)l * 1024 * INW + (size_t)(k0 + kk) * INW + srccol + c] * C.pre_g[l * 1024 + k0 + kk]; }
    __syncthreads();
    const int kk = tid & 63, wv = tid >> 6, n0 = wv * J;
    float acc[J];
#pragma unroll
    for (int j = 0; j < J; ++j) acc[j] = 0.f;
    for (int c = 0; c < GD; ++c) { const float w = Ws[kk * (GD + 1) + c];
#pragma unroll
        for (int jj = 0; jj < J / 4; ++jj) { const f32x4 g4 = *(const LAS f32x4*)(Gm + c * GS + n0 + 4 * jj);
            acc[4 * jj + 0] += w * g4[0]; acc[4 * jj + 1] += w * g4[1]; acc[4 * jj + 2] += w * g4[2]; acc[4 * jj + 3] += w * g4[3]; } }
    bf16_t* WT = C.W1T + (size_t)l * N1PAD * 1024;
#pragma unroll
    for (int j = 0; j < J; ++j) { const int n = n0 + j; const int row = (NP == 128 && n >= 64) ? (dst1 + n - 64) : (dst0 + n);
        WT[(size_t)row * 1024 + k0 + kk] = (bf16_t)(cvt_pk_bf16(acc[j], 0.f) & 0xffffu); }
    __syncthreads();
}
__device__ __forceinline__ void fold_item(const Ctx& C, int it, LAS unsigned char* lds) {
    const int l = it >> 7, r = it & 127, grp = r >> 4, kb = r & 15, k0 = kb * 64, tid = opaque_tid();
    LAS float* Gm = (LAS float*)lds;
    LAS float* Ws = (LAS float*)(lds + 40960);
    LAS float* Wc = (LAS float*)(lds + 69632);
    LAS float* tb = (LAS float*)(lds + 90112);
    if (grp < 4) {
        const int g = grp;
        for (int idx = tid; idx < 96 * 96; idx += 512) { const int c = idx / 96, n = idx - c * 96;
            Gm[c * 100 + n] = C.b_w[((size_t)(l * 4 + g) * 96 + c) * 96 + n] * C.b_scale[l * 384 + g * 96 + n]; }
        fold_compute<96, 96>(C, l, k0, 1152 + g * 96, Gm, Ws, C_B + g * 96, 0);
    } else {
        const int g = grp - 4;
        if (tid < 64) { float s, c; sincospif((float)tid * (1.0f / 32.0f), &s, &c); tb[tid] = c; tb[64 + tid] = s; }
        for (int idx = tid; idx < 4096; idx += 512) { const int m = idx >> 6, d = idx & 63; Wc[m * 65 + d] = C.c_w[((size_t)(l * 4 + g) * 64 + m) * 64 + d]; }
        __syncthreads();
        for (int idx = tid; idx < 4096; idx += 512) { const int c = idx >> 6, d = idx & 63; float gc = 0.f, gs = 0.f;
            for (int m = 0; m < 64; ++m) { const float w = Wc[m * 65 + d]; const int ph = (m * c) & 63; gc += tb[ph] * w; gs += tb[64 + ph] * w; }
            Gm[c * 132 + d] = gc; Gm[c * 132 + 64 + d] = gs; }
        fold_compute<64, 128>(C, l, k0, 1920 + g * 64, Gm, Ws, C_PC + g * 64, C_PS + g * 64);
    }
}
__device__ __forceinline__ const float* xrow_ptr(const Ctx& C, int t) { return t < TP ? C.xp + (size_t)t * 1024 : C.xs + (size_t)(t - TP) * 1024; }

__device__ __forceinline__ void p0_prologue(const Ctx& C, LAS unsigned char* lds) {
    const int tid = opaque_tid(), lane = tid & 63, wave = tid >> 6, G = gridDim.x, bid = blockIdx.x;
    for (int it = bid; it < 256; it += G) fold_item(C, it, lds);
    const int gw = bid * 8 + wave, NGW = G * 8;
    LAS float* scr = (LAS float*)(lds + wave * 8704);
    for (int it = gw; it < 2 * 1408; it += NGW) {
        const int l = it / 1408; int r = it - l * 1408;
        if (r < 896) { const int nb = r >> 4, kb = r & 15, dst = nb * 32;
            const int src = dst < 1152 ? dst : (dst < 1536 ? dst - 1152 + 1536 : dst - 1536 + 2176);
            transpose_item(C.w_in + (size_t)l * 1024 * INW, INW, src, C.pre_g + l * 1024, C.W1T + (size_t)l * N1PAD * 1024, dst, kb * 64, scr, lane);
        } else { r -= 896; const int nb = r >> 4, kb = r & 15;
            transpose_item(C.w_out + (size_t)l * 1024 * 1024, 1024, nb * 32, nullptr, C.WOT + (size_t)l * 1024 * 1024, nb * 32, kb * 64, scr, lane); }
    }
    const int gt = bid * 512 + tid, NGT = G * 512;
    for (int i = gt; i < 2 * 128 * 128; i += NGT) { const int l = i >> 14, r = i & 16383; *(u32x4*)(C.W1T + (size_t)l * N1PAD * 1024 + (size_t)2688 * 1024 + (size_t)r * 8) = (u32x4){0u, 0u, 0u, 0u}; }
    for (int i = gt; i < 2 * 4 * 128 * 128 / 2; i += NGT) { const f32x2 v = *(const f32x2*)(C.a_w_s + 2 * (size_t)i); *(unsigned*)(C.WSB + 2 * (size_t)i) = cvt_pk_bf16(v.x, v.y); }
    for (int i = gt; i < 256 * 512; i += NGT) { const int k2 = i >> 9, jj = i & 511, s2 = jj & 255; const int ph = (k2 * s2) & 255; float s, c; sincospif((float)ph * (1.0f / 128.0f), &s, &c);
        C.DQ[i] = (bf16_t)(cvt_pk_bf16(jj < 256 ? c : -s, 0.f) & 0xffffu); }
    for (int t = gw; t < T_TOK; t += NGW) {
        const f32x4* xr = (const f32x4*)xrow_ptr(C, t) + lane; f32x4 v[4]; float s = 0.f;
#pragma unroll
        for (int j = 0; j < 4; ++j) { v[j] = xr[64 * j]; s += (v[j].x * v[j].x + v[j].y * v[j].y) + (v[j].z * v[j].z + v[j].w * v[j].w); }
        const float r = rsqrtf(wave_sum(s) * (1.0f / 1024.0f) + EPS);
        u32x2* o = (u32x2*)(C.XB + (size_t)t * 1024) + lane;
#pragma unroll
        for (int j = 0; j < 4; ++j) { u32x2 w; w.x = cvt_pk_bf16(v[j].x * r, v[j].y * r); w.y = cvt_pk_bf16(v[j].z * r, v[j].w * r); o[64 * j] = w; }
    }
}

constexpr int VSTR = 136;
__device__ __forceinline__ void mixer_a_unit(const Ctx& C, int l, int unit, LAS unsigned char* lds) {
    const int tid = opaque_tid(), lane = tid & 63, w = tid >> 6, fr = lane & 15, fq = lane >> 4;
    const int c = unit >> 2, h = unit & 3, t0 = c * 128;
    LAS bf16_t* vt = (LAS bf16_t*)lds;
    {
        const int q = tid >> 2, part = tid & 3, d0 = part * 24;
        const bf16_t* src = C.PROJ + (size_t)(t0 + q) * LDP + C_V + h * 96 + d0;
        float v[24];
#pragma unroll
        for (int i = 0; i < 3; ++i) { const u32x4 p = *(const u32x4*)(src + 8 * i);
            v[8 * i + 0] = bf_lo(p.x); v[8 * i + 1] = bf_hi(p.x); v[8 * i + 2] = bf_lo(p.y); v[8 * i + 3] = bf_hi(p.y);
            v[8 * i + 4] = bf_lo(p.z); v[8 * i + 5] = bf_hi(p.z); v[8 * i + 6] = bf_lo(p.w); v[8 * i + 7] = bf_hi(p.w); }
        float s = 0.f;
#pragma unroll
        for (int i = 0; i < 24; ++i) s += v[i];
        s += __shfl_xor(s, 1); s += __shfl_xor(s, 2);
        const float mean = s * (1.0f / 96.0f); float q2 = 0.f;
#pragma unroll
        for (int i = 0; i < 24; ++i) { v[i] -= mean; q2 += v[i] * v[i]; }
        q2 += __shfl_xor(q2, 1); q2 += __shfl_xor(q2, 2);
        const float rstd = rsqrtf(q2 * (1.0f / 96.0f) + EPS);
        const float* lg = C.a_ln_g + l * 384 + h * 96 + d0; const float* lb = C.a_ln_b + l * 384 + h * 96 + d0;
#pragma unroll
        for (int i = 0; i < 24; ++i) { const float o = v[i] * rstd * lg[i] + lb[i]; vt[(d0 + i) * VSTR + q] = (bf16_t)(cvt_pk_bf16(o, 0.f) & 0xffffu); }
    }
    __syncthreads();
    bf16x8 af[4];
    const bf16_t* wsrow = C.WSB + ((size_t)(l * 4 + h) * 128 + 16 * w + fr) * 128 + 8 * fq;
#pragma unroll
    for (int ks = 0; ks < 4; ++ks) af[ks] = *(const bf16x8*)(wsrow + ks * 32);
    f32x4 acc[6];
#pragma unroll
    for (int nb = 0; nb < 6; ++nb) { acc[nb] = (f32x4){0.f, 0.f, 0.f, 0.f};
#pragma unroll
        for (int ks = 0; ks < 4; ++ks) { const bf16x8 bfr = *(const LAS bf16x8*)(vt + (nb * 16 + fr) * VSTR + ks * 32 + 8 * fq);
            acc[nb] = __builtin_amdgcn_mfma_f32_16x16x32_bf16(bfr, af[ks], acc[nb], 0, 0, 0); } }
    const int p = 16 * w + fr; const size_t tok = (size_t)(t0 + p);
    const float bias = C.a_b_s[(l * 4 + h) * 128 + p];
#pragma unroll
    for (int nb = 0; nb < 6; ++nb) { const int dc = h * 96 + nb * 16 + 4 * fq;
        const u32x2 uu = *(const u32x2*)(C.PROJ + tok * LDP + C_U + dc), gg = *(const u32x2*)(C.PROJ + tok * LDP + C_AG + dc);
        u32x2 o; o.x = cvt_pk_bf16((acc[nb][0] + bias) * bf_lo(uu.x) * bf_lo(gg.x), (acc[nb][1] + bias) * bf_hi(uu.x) * bf_hi(gg.x));
        o.y = cvt_pk_bf16((acc[nb][2] + bias) * bf_lo(uu.y) * bf_lo(gg.y), (acc[nb][3] + bias) * bf_hi(uu.y) * bf_hi(gg.y));
        *(u32x2*)(C.YM + tok * 1024 + dc) = o; }
    __syncthreads();
}

__device__ __forceinline__ void mixer_b_item(const Ctx& C, int item) {
    const int t = item / 48, cb = item - t * 48, g = cb / 12, half = 1 << g;
    int S, pos, sb;
    if (t < TP) { S = 2048; pos = t & 2047; sb = t - pos; } else { S = 4096; pos = (t - TP) & 4095; sb = t - pos; }
    const int lo = max(pos - half, 0), hi = min(pos + half, S);
    float s[8];
#pragma unroll
    for (int i = 0; i < 8; ++i) s[i] = 0.f;
    const bf16_t* base = C.PROJ + C_B + cb * 8;
    for (int tau = lo; tau < hi; ++tau) { const u32x4 p = *(const u32x4*)(base + (size_t)(sb + tau) * LDP);
        s[0] += bf_lo(p.x); s[1] += bf_hi(p.x); s[2] += bf_lo(p.y); s[3] += bf_hi(p.y); s[4] += bf_lo(p.z); s[5] += bf_hi(p.z); s[6] += bf_lo(p.w); s[7] += bf_hi(p.w); }
    const float inv = 1.0f / (float)(hi - lo);
    const u32x4 zc = *(const u32x4*)(base + (size_t)t * LDP), gt = *(const u32x4*)(C.PROJ + (size_t)t * LDP + C_BG + cb * 8);
    u32x4 o;
    o.x = cvt_pk_bf16((s[0] * inv - bf_lo(zc.x)) * bf_lo(gt.x), (s[1] * inv - bf_hi(zc.x)) * bf_hi(gt.x));
    o.y = cvt_pk_bf16((s[2] * inv - bf_lo(zc.y)) * bf_lo(gt.y), (s[3] * inv - bf_hi(zc.y)) * bf_hi(gt.y));
    o.z = cvt_pk_bf16((s[4] * inv - bf_lo(zc.z)) * bf_lo(gt.z), (s[5] * inv - bf_hi(zc.z)) * bf_hi(gt.z));
    o.w = cvt_pk_bf16((s[6] * inv - bf_lo(zc.w)) * bf_lo(gt.w), (s[7] * inv - bf_hi(zc.w)) * bf_hi(gt.w));
    *(u32x4*)(C.YM + (size_t)t * 1024 + 384 + cb * 8) = o;
}

template <int R>
__device__ __forceinline__ void dft1_item(const Ctx& C, int seqtok0, int S, int unit0, int s2, int cb) {
    u32x2 pc[R], ps[R];
#pragma unroll
    for (int s1 = 0; s1 < R; ++s1) { const bf16_t* rp = C.PROJ + (size_t)(seqtok0 + 256 * s1 + s2) * LDP + 4 * cb;
        pc[s1] = *(const u32x2*)(rp + C_PC); ps[s1] = *(const u32x2*)(rp + C_PS); }
    const float scale = rsqrtf(64.0f * (float)S);
    for (int k1 = 0; k1 < R; ++k1) {
        float sn, cs; sincospif((float)k1 * (2.0f / (float)R), &sn, &cs);
        float wr = 1.f, wi = 0.f, are[4], aim[4];
#pragma unroll
        for (int c = 0; c < 4; ++c) { are[c] = 0.f; aim[c] = 0.f; }
#pragma unroll
        for (int s1 = 0; s1 < R; ++s1) {
            const float a[4] = {bf_lo(pc[s1].x), bf_hi(pc[s1].x), bf_lo(pc[s1].y), bf_hi(pc[s1].y)};
            const float b[4] = {bf_lo(ps[s1].x), bf_hi(ps[s1].x), bf_lo(ps[s1].y), bf_hi(ps[s1].y)};
#pragma unroll
            for (int c = 0; c < 4; ++c) { are[c] += wr * a[c] - wi * b[c]; aim[c] += wr * b[c] + wi * a[c]; }
            const float nwr = wr * cs - wi * sn, nwi = wr * sn + wi * cs; wr = nwr; wi = nwi;
        }
        const int ph = (k1 * s2) & (S - 1);
        float ts, tc; sincospif((float)ph * (2.0f / (float)S), &ts, &tc); ts *= scale; tc *= scale;
        bf16_t* ob = C.APT + ((size_t)(unit0 + k1) * 256 + 4 * cb) * 512 + s2;
#pragma unroll
        for (int c = 0; c < 4; ++c) { const float ore = are[c] * tc - aim[c] * ts, oim = are[c] * ts + aim[c] * tc;
            const unsigned pk = cvt_pk_bf16(ore, oim); ob[c * 512] = (bf16_t)(pk & 0xffffu); ob[c * 512 + 256] = (bf16_t)(pk >> 16); }
    }
}

__device__ __forceinline__ void p2_mixers(const Ctx& C, int l, LAS unsigned char* lds) {
    const int G = gridDim.x, bid = blockIdx.x, tid = opaque_tid();
    for (int u = bid; u < 1536; u += G) mixer_a_unit(C, l, u, lds);
    const int gt = bid * 512 + tid, NGT = G * 512;
    for (int it = gt; it < 65536 + 262144; it += NGT) {
        if (it < 65536) { const int s2 = it & 255, cb = (it >> 8) & 63, b = it >> 14; dft1_item<16>(C, TP + b * 4096, 4096, 128 + b * 16, s2, cb); }
        else { const int i2 = it - 65536; const int s2 = i2 & 255, cb = (i2 >> 8) & 63, b = i2 >> 14; dft1_item<8>(C, b * 2048, 2048, b * 8, s2, cb); }
    }
    for (int it = gt; it < T_TOK * 48; it += NGT) mixer_b_item(C, it);
}

__device__ __forceinline__ void p5_residual(const Ctx& C, int l) {
    const int tid = opaque_tid(), lane = tid & 63, wave = tid >> 6, G = gridDim.x, bid = blockIdx.x;
    const int gw = bid * 8 + wave, NGW = G * 8;
    const float* pg = C.post_g + l * 1024;
    for (int t = gw; t < T_TOK; t += NGW) {
        const bf16_t* yr = C.YO + (size_t)t * 1024;
        float y[16]; float ss = 0.f;
#pragma unroll
        for (int j = 0; j < 2; ++j) { const u32x4 p = *(const u32x4*)(yr + 8 * lane + 512 * j);
            y[8 * j + 0] = bf_lo(p.x); y[8 * j + 1] = bf_hi(p.x); y[8 * j + 2] = bf_lo(p.y); y[8 * j + 3] = bf_hi(p.y);
            y[8 * j + 4] = bf_lo(p.z); y[8 * j + 5] = bf_hi(p.z); y[8 * j + 6] = bf_lo(p.w); y[8 * j + 7] = bf_hi(p.w); }
#pragma unroll
        for (int i = 0; i < 16; ++i) ss += y[i] * y[i];
        const float r = rsqrtf(wave_sum(ss) * (1.0f / 1024.0f) + EPS);
        const float* xo = (l == 0) ? xrow_ptr(C, t) : (const float*)(C.out + (size_t)t * 1024);
        float* orow = C.out + (size_t)t * 1024;
        float xn[16]; float ss2 = 0.f;
#pragma unroll
        for (int j = 0; j < 2; ++j) { const int col = 8 * lane + 512 * j;
            const f32x4 xa = *(const f32x4*)(xo + col), xb = *(const f32x4*)(xo + col + 4), ga = *(const f32x4*)(pg + col), gb = *(const f32x4*)(pg + col + 4);
            f32x4 oa, ob;
#pragma unroll
            for (int i = 0; i < 4; ++i) { oa[i] = xa[i] + y[8 * j + i] * r * ga[i]; ob[i] = xb[i] + y[8 * j + 4 + i] * r * gb[i]; xn[8 * j + i] = oa[i]; xn[8 * j + 4 + i] = ob[i]; ss2 += oa[i] * oa[i] + ob[i] * ob[i]; }
            *(f32x4*)(orow + col) = oa; *(f32x4*)(orow + col + 4) = ob; }
        if (l == 0) {
            const float r2 = rsqrtf(wave_sum(ss2) * (1.0f / 1024.0f) + EPS);
#pragma unroll
            for (int j = 0; j < 2; ++j) { u32x4 w; w.x = cvt_pk_bf16(xn[8 * j + 0] * r2, xn[8 * j + 1] * r2); w.y = cvt_pk_bf16(xn[8 * j + 2] * r2, xn[8 * j + 3] * r2);
                w.z = cvt_pk_bf16(xn[8 * j + 4] * r2, xn[8 * j + 5] * r2); w.w = cvt_pk_bf16(xn[8 * j + 6] * r2, xn[8 * j + 7] * r2);
                *(u32x4*)(C.XB + (size_t)t * 1024 + 8 * lane + 512 * j) = w; }
        }
    }
}

__global__ void __launch_bounds__(512, 2) fwd_kernel(Args a) {
    extern __shared__ __attribute__((aligned(16))) unsigned char shm[];
    LAS unsigned char* lds = (LAS unsigned char*)shm;
    cg::grid_group grid = cg::this_grid();
    Ctx C;
    C.xp = a.in[0]; C.xs = a.in[1]; C.pre_g = a.in[2]; C.w_in = a.in[3]; C.a_ln_g = a.in[4]; C.a_ln_b = a.in[5]; C.a_w_s = a.in[6]; C.a_b_s = a.in[7];
    C.b_w = a.in[8]; C.b_scale = a.in[9]; C.c_w = a.in[10]; C.w_out = a.in[11]; C.post_g = a.in[12];
    C.out = a.out;
    C.W1T = (bf16_t*)(a.ws + OFF_W1T); C.WOT = (bf16_t*)(a.ws + OFF_WOT); C.WSB = (bf16_t*)(a.ws + OFF_WSB); C.DQ = (bf16_t*)(a.ws + OFF_DQ);
    C.XB = (bf16_t*)(a.ws + OFF_XB); C.APT = (bf16_t*)(a.ws + OFF_XB); C.PROJ = (bf16_t*)(a.ws + OFF_PROJ); C.YO = (bf16_t*)(a.ws + OFF_PROJ); C.YM = (bf16_t*)(a.ws + OFF_YM);
    const int G = gridDim.x, bid = blockIdx.x;
    for (int ph = a.ph_lo; ph < a.ph_hi; ++ph) {
        if (ph == 0) p0_prologue(C, lds);
        else {
            const int l = (ph - 1) / 5, sub = (ph - 1) % 5;
            if (sub == 0) { pg8::Gemm g{C.XB, C.W1T + (size_t)l * N1PAD * 1024, T_TOK, N1PAD, 1024}; pg8::StaticOrder S; S.init(g.M, g.N, G, bid); EpiProj E{C.PROJ}; pg8::gemm_phase(lds, g, S, E); }
            else if (sub == 1) p2_mixers(C, l, lds);
            else if (sub == 2) { pg8::Gemm g{C.DQ, C.APT, 256, 192 * 256, 512}; pg8::StaticOrder S; S.init(g.M, g.N, G, bid); EpiDft E{C.PROJ, C.YM}; pg8::gemm_phase(lds, g, S, E); }
            else if (sub == 3) { pg8::Gemm g{C.YM, C.WOT + (size_t)l * 1024 * 1024, T_TOK, 1024, 1024}; pg8::StaticOrder S; S.init(g.M, g.N, G, bid); EpiY E{C.YO}; pg8::gemm_phase(lds, g, S, E); }
            else p5_residual(C, l);
        }
        if (ph + 1 < a.ph_hi) grid.sync();
    }
}

extern "C" void kernel_launch(void* const* d_in, const int* in_sizes, int n_in, void* d_out, int out_size, void* d_ws, size_t ws_size, hipStream_t stream) {
    static int grid = 0;
    if (grid == 0) {
        if (n_in != 13 || ws_size < WS_END) { fprintf(stderr, "kernel_launch: need 13 inputs and >= %zu bytes of workspace; got n_in %d, ws %zu\n", (size_t)WS_END, n_in, ws_size); grid = -1; return; }
        int dev = 0, cus = 0, per_cu = 0;
        hipGetDevice(&dev); hipDeviceGetAttribute(&cus, hipDeviceAttributeMultiprocessorCount, dev);
        if (hipFuncSetAttribute((const void*)fwd_kernel, hipFuncAttributeMaxDynamicSharedMemorySize, LDS_BYTES) != hipSuccess) { fprintf(stderr, "kernel_launch: hipFuncSetAttribute failed\n"); grid = -1; return; }
        if (hipOccupancyMaxActiveBlocksPerMultiprocessor(&per_cu, (const void*)fwd_kernel, 512, LDS_BYTES) != hipSuccess || per_cu < 1) { fprintf(stderr, "kernel_launch: occupancy query says %d\n", per_cu); per_cu = 1; }
        (void)hipGetLastError();
        grid = cus;
    }
    if (grid < 0) return;
    Args a{};
    for (int i = 0; i < 13; ++i) a.in[i] = (const float*)d_in[i];
    a.out = (float*)d_out; a.ws = (unsigned char*)d_ws;
#if N_LAUNCH_MODE == 1
    a.ph_lo = 0; a.ph_hi = 11;
    void* args[] = {&a};
    hipError_t e = hipLaunchCooperativeKernel((const void*)fwd_kernel, dim3(grid), dim3(512), args, LDS_BYTES, stream);
    if (e != hipSuccess) fprintf(stderr, "cooperative launch failed: %s (grid %d)\n", hipGetErrorString(e), grid);
#else
    for (int ph = 0; ph < 11; ++ph) { a.ph_lo = ph; a.ph_hi = ph + 1; hipLaunchKernelGGL(fwd_kernel, dim3(grid), dim3(512), LDS_BYTES, stream, a); }
#endif
}
```

```cpp
#include <hip/hip_runtime.h>
#include <hip/hip_cooperative_groups.h>
#include <cstdio>
#include <cstdint>
namespace cg = cooperative_groups;

#ifndef GEMM_ALIGN
#define GEMM_ALIGN true
#endif
#ifndef GEMM_SP2
#define GEMM_SP2 true
#endif
constexpr bool GA = GEMM_ALIGN, GS = GEMM_SP2;
#ifndef PROBE_REPEAT
#define PROBE_REPEAT -1
#endif
#ifndef N_LAUNCH_MODE
#define N_LAUNCH_MODE 1
#endif

#define LAS __attribute__((address_space(3)))
typedef unsigned short bf16_t;
typedef short bf16x8 __attribute__((ext_vector_type(8)));
typedef float f32x4 __attribute__((ext_vector_type(4)));
typedef float f32x2 __attribute__((ext_vector_type(2)));
typedef unsigned u32x4 __attribute__((ext_vector_type(4)));
typedef unsigned u32x2 __attribute__((ext_vector_type(2)));

constexpr int T_TOK = 49152, TP = 32768, DM = 1024, INW = 2432;
constexpr int LDP = 1792;
constexpr int N1PAD = 2816;
constexpr int C_U = 0, C_V = 384, C_BG = 768, C_CG = 1152, C_B = 1408, R_B = 1792, R_PC = 2304, R_PS = 2560;
constexpr float EPS = 1e-6f;
constexpr size_t OFF_W1T = 0;
constexpr size_t OFF_WOT = OFF_W1T + (size_t)2 * N1PAD * 1024 * 2;
constexpr size_t OFF_WSB = OFF_WOT + (size_t)2 * 1024 * 1024 * 2;
constexpr size_t OFF_DQ = OFF_WSB + (size_t)2 * 4 * 128 * 128 * 2;
constexpr size_t OFF_BAR = OFF_DQ + (size_t)256 * 512 * 2;
constexpr size_t OFF_RINV = OFF_BAR + 32768;
constexpr size_t OFF_XB = OFF_RINV + (size_t)T_TOK * 4;
constexpr size_t OFF_PROJ = OFF_XB + (size_t)T_TOK * 1024 * 2;
constexpr size_t OFF_PT = OFF_PROJ + (size_t)T_TOK * LDP * 2;
constexpr size_t OFF_YM = OFF_PT + (size_t)512 * T_TOK * 2;
constexpr size_t WS_END = OFF_YM + (size_t)T_TOK * 1024 * 2;
constexpr int LDS_BYTES = 131072 + 64;

struct Args {
    const float* in[13];
    float* out;
    unsigned char* ws;
    int ph_lo, ph_hi;
};

__device__ __forceinline__ unsigned cvt_pk_bf16(float lo, float hi) { unsigned r; asm("v_cvt_pk_bf16_f32 %0, %1, %2" : "=v"(r) : "v"(lo), "v"(hi)); return r; }
__device__ __forceinline__ float bf_lo(unsigned w) { return __uint_as_float(w << 16); }
__device__ __forceinline__ float bf_hi(unsigned w) { return __uint_as_float(w & 0xffff0000u); }
__device__ __forceinline__ float wave_sum(float v) {
#pragma unroll
    for (int o = 1; o < 64; o <<= 1) v += __shfl_xor(v, o);
    return v;
}
__device__ __forceinline__ float sigmoid_fast(float z) { return __builtin_amdgcn_rcpf(1.0f + __builtin_amdgcn_exp2f(-1.4426950409f * z)); }
__device__ __forceinline__ float gelu_tanh(float x) { const float z = 1.5957691216f * (x + 0.044715f * x * x * x); return x * sigmoid_fast(z); }
__device__ __forceinline__ float silu_f(float x) { return x * sigmoid_fast(x); }

__device__ __forceinline__ int opaque_tid() { int t = threadIdx.x; asm volatile("" : "+v"(t)); return t; }
namespace pg8 {
constexpr int BM = 256, BK = 64, HALF = 128, HTB = HALF * BK * 2, STAGE_BYTES = 8 * HTB, NXCD = 8, WGM = 8;
__host__ __device__ __forceinline__ int lds_byte(int r, int c) { const int st = (r >> 4) * 2 + (c >> 5), rr = r & 15, cc = c & 31, ob = rr * 64 + cc * 2; return st * 1024 + (ob ^ (((ob >> 9) & 1) << 5)); }
__host__ __device__ __forceinline__ void stage_rc(int b, int& R, int& C) { const int st = b / 1024, sb = b % 1024, swz = sb ^ (((sb >> 9) & 1) << 5); R = (st >> 1) * 16 + swz / 64; C = (st & 1) * 32 + (swz % 64) / 2; }
__host__ __device__ __forceinline__ int perm32(int rho) { const int n = rho >> 4, i = rho & 15; return 8 * (i >> 2) + 4 * n + (i & 3); }
struct Unit { int pm, pn, kind, flag; const char* A; const char* B; };
struct Gemm { const bf16_t* A; const bf16_t* Bt; int M, N, K; };
struct StaticOrder {
    int nM, nN, nwg, G, c;
    __device__ void init(int M, int N, int G_, int c_) { nM = M / BM; nN = N / BM; nwg = nM * nN; G = G_; c = c_; }
    __device__ bool map(long L, int& pm, int& pn) const {
        if (L >= nwg) return false;
        int wgid = (int)L; { const int q = nwg / NXCD, r = nwg % NXCD, xcd = wgid % NXCD, off = wgid / NXCD; wgid = (xcd < r ? xcd * (q + 1) : r * (q + 1) + (xcd - r) * q) + off; }
        const int nig = WGM * nN, gid = wgid / nig, fm = gid * WGM, gsz = (nM - fm) < WGM ? (nM - fm) : WGM;
        pm = fm + ((wgid % nig) % gsz); pn = (wgid % nig) / gsz; return true;
    }
};
struct SchedPlain {
    StaticOrder o; const char* A; const char* Bt; size_t tstep;
    __device__ void init(const Gemm& g, int G, int c) { o.init(g.M, g.N, G, c); A = (const char*)g.A; Bt = (const char*)g.Bt; tstep = (size_t)256 * g.K * 2; }
    __device__ bool next(int i, Unit& u) const { if (!o.map((long)i * o.G + o.c, u.pm, u.pn)) return false; u.kind = 0; u.flag = 0; u.A = A + (size_t)u.pm * tstep; u.B = Bt + (size_t)u.pn * tstep; return true; }
    __device__ __forceinline__ void done(const Unit&, int) const {}
};
struct SchedG1 {
    StaticOrder o; const char* XB; const char* W; size_t tstep;
    __device__ void init(const bf16_t* xb, const bf16_t* w1t, int G, int c) { o.init(T_TOK, 2304, G, c); XB = (const char*)xb; W = (const char*)w1t; tstep = (size_t)256 * 1024 * 2; }
    unsigned* cnt;
    __device__ bool next(int i, Unit& u) const {
        const long L = (long)i * o.G + o.c;
        if (L < 1728) { o.map(L, u.pm, u.pn); u.kind = 0; u.flag = 0;     u.A = XB + (size_t)u.pm * tstep; u.B = W + (size_t)u.pn * tstep; return true; }
        const int idx = (int)(L - 1728); if (idx >= 384) return false;
        u.pm = idx & 1; u.pn = idx >> 1; u.kind = 1; u.flag = 0; u.A = W + (size_t)(9 + u.pm) * tstep; u.B = XB + (size_t)u.pn * tstep; return true;
    }
    unsigned x, nwav, *xsub;
    __device__ __forceinline__ void done(const Unit& u, int lane) const {
        if (u.flag) {
            asm volatile("s_waitcnt vmcnt(0)" ::: "memory");
            if (lane == 0) {
                const unsigned old = __hip_atomic_fetch_add(xsub + 64 * x, 1u, __ATOMIC_RELAXED, __HIP_MEMORY_SCOPE_AGENT);
                if (old + 1u == nwav) {
                    __builtin_amdgcn_fence(__ATOMIC_RELEASE, "agent");
                    asm volatile("s_waitcnt vmcnt(0)" ::: "memory");
                    __hip_atomic_fetch_add(cnt, 1u, __ATOMIC_RELAXED, __HIP_MEMORY_SCOPE_AGENT);
                }
            }
        }
    }
};
template <bool ALIGN_EPI, bool SP2, class Epi, class Sched>
__device__ __forceinline__ void gemm_phase(LAS unsigned char* lds, const int K, const Sched& S, const Epi& E) {
    const int tid = opaque_tid(), wid = __builtin_amdgcn_readfirstlane(tid >> 6), lane = tid & 63, wr = wid >> 2, wc = wid & 3, fr = lane & 15, fq = lane >> 4;
    const int nt = K / BK;
    unsigned voffA[2], voffB[2];
#pragma unroll
    for (int i = 0; i < 2; ++i) { int R, C; stage_rc(tid * 16 + i * 8192, R, C); const int Rb = (R & ~31) + perm32(R & 31);
        voffA[i] = (unsigned)(R * K + C) * 2u; voffB[i] = (unsigned)(Rb * K + C) * 2u; }
    const size_t kstep = (size_t)(BK * 2);
    const size_t hstep = (size_t)HALF * K * 2;
    const unsigned ldsw = (unsigned)wid * 1024u;
    const int aoff = lds_byte(wr * 64 + fr, fq * 8), boff = lds_byte(wc * 32 + fr, fq * 8);
#define PG8_SA(b, h) (((b) * 2 + (h)) * HTB)
#define PG8_SB(b, h) ((4 + (b) * 2 + (h)) * HTB)
#define PG8_STAGE(bufoff, gbase, voff) do { _Pragma("unroll") for (int _i = 0; _i < 2; ++_i) \
        __builtin_amdgcn_global_load_lds((const unsigned*)((const char*)(gbase) + (voff)[_i]), (LAS unsigned*)(lds + (bufoff) + ldsw + _i * 8192), 16, 0, 0); } while (0)
#define PG8_LDA(dst, b, h) do { _Pragma("unroll") for (int m = 0; m < 4; ++m) _Pragma("unroll") for (int k = 0; k < 2; ++k) dst[m][k] = *(const LAS bf16x8*)(lds + PG8_SA(b, h) + aoff + m * 2048 + k * 1024); } while (0)
#define PG8_LDB(dst, b, h) do { _Pragma("unroll") for (int n = 0; n < 2; ++n) _Pragma("unroll") for (int k = 0; k < 2; ++k) dst[n][k] = *(const LAS bf16x8*)(lds + PG8_SB(b, h) + boff + n * 2048 + k * 1024); } while (0)
#define PG8_MMA(ai, bj, At, Bt) do { __builtin_amdgcn_s_setprio(1); _Pragma("unroll") for (int m = 0; m < 4; ++m) _Pragma("unroll") for (int n = 0; n < 2; ++n) _Pragma("unroll") for (int k = 0; k < 2; ++k) \
        acc[ai][bj][m][n] = __builtin_amdgcn_mfma_f32_16x16x32_bf16(Bt[n][k], At[m][k], acc[ai][bj][m][n], 0, 0, 0); __builtin_amdgcn_s_setprio(0); } while (0)
#define PG8_WAIT_V(n) asm volatile("s_waitcnt vmcnt(" #n ")" ::: "memory")
#define PG8_WAIT_L(n) asm volatile("s_waitcnt lgkmcnt(" #n ")" ::: "memory")
#define PG8_BAR __builtin_amdgcn_s_barrier()
#define PG8_SCHED __builtin_amdgcn_sched_barrier(0)
    Unit cur, nxt; int ui = 0;
    if (!S.next(0, cur)) return;
    f32x4 acc[2][2][4][2];
#pragma unroll
    for (int a = 0; a < 2; ++a)
#pragma unroll
        for (int b = 0; b < 2; ++b)
#pragma unroll
            for (int m = 0; m < 4; ++m)
#pragma unroll
                for (int n = 0; n < 2; ++n) acc[a][b][m][n] = (f32x4){0.f, 0.f, 0.f, 0.f};
    bf16x8 At[4][2], B0[2][2], B1[2][2];
    const char* cA = cur.A; const char* cB = cur.B;
    if constexpr (SP2) {
        PG8_STAGE(PG8_SB(0, 0), cB, voffB); PG8_STAGE(PG8_SB(0, 1), cB + hstep, voffB); PG8_STAGE(PG8_SA(0, 0), cA, voffA); PG8_STAGE(PG8_SA(0, 1), cA + hstep, voffA);
        if (wr == 1) PG8_BAR;
        PG8_WAIT_V(2); PG8_BAR;
        PG8_STAGE(PG8_SB(1, 0), cB + kstep, voffB); PG8_STAGE(PG8_SA(1, 0), cA + kstep, voffA); PG8_STAGE(PG8_SB(1, 1), cB + hstep + kstep, voffB);
        PG8_WAIT_V(6); PG8_BAR;
    } else {
    PG8_STAGE(PG8_SB(0, 0), cB, voffB); PG8_STAGE(PG8_SA(0, 0), cA, voffA); PG8_STAGE(PG8_SB(0, 1), cB + hstep, voffB); PG8_STAGE(PG8_SA(0, 1), cA + hstep, voffA);
    if (wr == 1) PG8_BAR;
    PG8_WAIT_V(4); PG8_BAR;
    PG8_STAGE(PG8_SB(1, 0), cB + kstep, voffB); PG8_STAGE(PG8_SA(1, 0), cA + kstep, voffA); PG8_STAGE(PG8_SB(1, 1), cB + hstep + kstep, voffB);
    PG8_WAIT_V(6); PG8_BAR;
    }
    for (;;) {
        const bool has_next = S.next(ui + 1, nxt);
        const char* nA = has_next ? nxt.A : cA; const char* nB = has_next ? nxt.B : cB;
        for (int t = 0; t < nt; t += 2) {
            const bool last = (t == nt - 2);
            const char* a1 = cA + (size_t)(t + 1) * kstep;
            const char* a2 = last ? nA : cA + (size_t)(t + 2) * kstep; const char* b2 = last ? nB : cB + (size_t)(t + 2) * kstep;
            const char* a3 = a2 + kstep; const char* b3 = b2 + kstep;
            if constexpr (SP2) {
            PG8_LDB(B0, 0, 0); PG8_LDB(B1, 0, 1); PG8_SCHED; PG8_LDA(At, 0, 0); PG8_STAGE(PG8_SA(1, 1), a1 + hstep, voffA);
            PG8_WAIT_V(8); PG8_WAIT_L(0); PG8_BAR; PG8_MMA(0, 0, At, B0); PG8_MMA(0, 1, At, B1); PG8_BAR; PG8_SCHED;
            PG8_LDA(At, 0, 1); PG8_STAGE(PG8_SB(0, 0), b2, voffB); PG8_STAGE(PG8_SB(0, 1), b2 + hstep, voffB); PG8_STAGE(PG8_SA(0, 0), a2, voffA);
            PG8_WAIT_V(8); PG8_WAIT_L(0); PG8_BAR; PG8_MMA(1, 0, At, B0); PG8_MMA(1, 1, At, B1); PG8_BAR; PG8_SCHED;
            PG8_LDB(B0, 1, 0); PG8_LDB(B1, 1, 1); PG8_SCHED; PG8_LDA(At, 1, 0); PG8_STAGE(PG8_SA(0, 1), a2 + hstep, voffA);
            PG8_WAIT_V(8); PG8_WAIT_L(0); PG8_BAR; PG8_MMA(0, 0, At, B0); PG8_MMA(0, 1, At, B1); PG8_BAR; PG8_SCHED;
            PG8_LDA(At, 1, 1); PG8_STAGE(PG8_SB(1, 0), b3, voffB); PG8_STAGE(PG8_SB(1, 1), b3 + hstep, voffB); PG8_STAGE(PG8_SA(1, 0), a3, voffA);
            PG8_WAIT_V(8); PG8_WAIT_L(0); PG8_BAR; PG8_MMA(1, 0, At, B0); PG8_MMA(1, 1, At, B1); PG8_BAR; PG8_SCHED;
            } else {
            PG8_LDB(B0, 0, 0); PG8_SCHED; PG8_LDA(At, 0, 0); PG8_STAGE(PG8_SA(1, 1), a1 + hstep, voffA);
            PG8_WAIT_L(8); PG8_BAR; PG8_WAIT_L(0); PG8_MMA(0, 0, At, B0); PG8_BAR; PG8_SCHED;
            PG8_LDB(B1, 0, 1); PG8_STAGE(PG8_SB(0, 0), b2, voffB);
            PG8_BAR; PG8_WAIT_L(0); PG8_MMA(0, 1, At, B1); PG8_BAR;
            PG8_LDA(At, 0, 1); PG8_STAGE(PG8_SA(0, 0), a2, voffA);
            PG8_BAR; PG8_WAIT_L(0); PG8_MMA(1, 0, At, B0); PG8_BAR; PG8_SCHED;
            PG8_STAGE(PG8_SB(0, 1), b2 + hstep, voffB);
            PG8_WAIT_V(6); PG8_BAR; PG8_MMA(1, 1, At, B1); PG8_BAR;
            PG8_LDB(B0, 1, 0); PG8_SCHED; PG8_LDA(At, 1, 0); PG8_STAGE(PG8_SA(0, 1), a2 + hstep, voffA);
            PG8_WAIT_L(8); PG8_BAR; PG8_WAIT_L(0); PG8_MMA(0, 0, At, B0); PG8_BAR; PG8_SCHED;
            PG8_LDB(B1, 1, 1); PG8_STAGE(PG8_SB(1, 0), b3, voffB);
            PG8_BAR; PG8_WAIT_L(0); PG8_MMA(0, 1, At, B1); PG8_BAR;
            PG8_LDA(At, 1, 1); PG8_STAGE(PG8_SA(1, 0), a3, voffA);
            PG8_BAR; PG8_WAIT_L(0); PG8_MMA(1, 0, At, B0); PG8_BAR; PG8_SCHED;
            PG8_STAGE(PG8_SB(1, 1), b3 + hstep, voffB);
            PG8_WAIT_V(6); PG8_BAR; PG8_MMA(1, 1, At, B1); PG8_BAR;
                    }
        }
        if constexpr (ALIGN_EPI) { if (wr == 0) PG8_BAR; }
        E(acc, cur, wr, wc, fr, fq);
        S.done(cur, lane);
        if (!has_next) break;
#pragma unroll
        for (int a = 0; a < 2; ++a)
#pragma unroll
            for (int b = 0; b < 2; ++b)
#pragma unroll
                for (int m = 0; m < 4; ++m)
#pragma unroll
                    for (int n = 0; n < 2; ++n) acc[a][b][m][n] = (f32x4){0.f, 0.f, 0.f, 0.f};
        cur = nxt; cA = nA; cB = nB; ++ui;
        if constexpr (ALIGN_EPI) { if (wr == 1) PG8_BAR; }
    }
    PG8_WAIT_V(0);
    if constexpr (!ALIGN_EPI) { if (wr == 0) PG8_BAR; }
    PG8_BAR;
#undef PG8_SA
#undef PG8_SB
#undef PG8_STAGE
#undef PG8_LDA
#undef PG8_LDB
#undef PG8_MMA
#undef PG8_WAIT_V
#undef PG8_WAIT_L
#undef PG8_BAR
#undef PG8_SCHED
}
}
using pg8::Unit;

template <int ACT> __device__ __forceinline__ float act_f(float x) { if (ACT == 0) return gelu_tanh(x); if (ACT == 1) return silu_f(x); return x; }

struct EpiProj {
    bf16_t* O; bf16_t* PT;
    template <int ACT0, int ACT1> __device__ __forceinline__ void body(const f32x4 (&acc)[2][2][4][2], bf16_t* base, size_t ld, int nbj) const {
#pragma unroll
        for (int ai = 0; ai < 2; ++ai)
#pragma unroll
            for (int m = 0; m < 4; ++m) { bf16_t* rowp = base + (size_t)(ai * 128 + m * 16) * ld;
#pragma unroll
                for (int bj = 0; bj < 2; ++bj) { if (bj < nbj) { const f32x4 v0 = acc[ai][bj][m][0], v1 = acc[ai][bj][m][1]; u32x4 w;
                    if (bj == 0) { w.x = cvt_pk_bf16(act_f<ACT0>(v0[0]), act_f<ACT0>(v0[1])); w.y = cvt_pk_bf16(act_f<ACT0>(v0[2]), act_f<ACT0>(v0[3]));
                        w.z = cvt_pk_bf16(act_f<ACT0>(v1[0]), act_f<ACT0>(v1[1])); w.w = cvt_pk_bf16(act_f<ACT0>(v1[2]), act_f<ACT0>(v1[3])); }
                    else { w.x = cvt_pk_bf16(act_f<ACT1>(v0[0]), act_f<ACT1>(v0[1])); w.y = cvt_pk_bf16(act_f<ACT1>(v0[2]), act_f<ACT1>(v0[3]));
                        w.z = cvt_pk_bf16(act_f<ACT1>(v1[0]), act_f<ACT1>(v1[1])); w.w = cvt_pk_bf16(act_f<ACT1>(v1[2]), act_f<ACT1>(v1[3])); }
                    *(u32x4*)(rowp + bj * 128) = w; } } }
    }
    __device__ __forceinline__ void body_ug(const f32x4 (&acc)[2][2][4][2], bf16_t* base) const {
#pragma unroll
        for (int ai = 0; ai < 2; ++ai)
#pragma unroll
            for (int m = 0; m < 4; ++m) { const f32x4 u0 = acc[ai][0][m][0], u1 = acc[ai][0][m][1], g0 = acc[ai][1][m][0], g1 = acc[ai][1][m][1]; u32x4 w;
                w.x = cvt_pk_bf16(gelu_tanh(u0[0]) * silu_f(g0[0]), gelu_tanh(u0[1]) * silu_f(g0[1])); w.y = cvt_pk_bf16(gelu_tanh(u0[2]) * silu_f(g0[2]), gelu_tanh(u0[3]) * silu_f(g0[3]));
                w.z = cvt_pk_bf16(gelu_tanh(u1[0]) * silu_f(g1[0]), gelu_tanh(u1[1]) * silu_f(g1[1])); w.w = cvt_pk_bf16(gelu_tanh(u1[2]) * silu_f(g1[2]), gelu_tanh(u1[3]) * silu_f(g1[3]));
                *(u32x4*)(base + (size_t)(ai * 128 + m * 16) * LDP) = w; }
    }
    __device__ __forceinline__ void operator()(const f32x4 (&acc)[2][2][4][2], const Unit& u, int wr, int wc, int fr, int fq) const {
        const int row0 = u.pm * 256 + wr * 64 + fr, cw = wc * 32 + 8 * fq;
        if (u.kind == 1) { body<2, 2>(acc, PT + (size_t)row0 * T_TOK + u.pn * 256 + cw, (size_t)T_TOK, 2); return; }
        if (u.pn < 3) { body_ug(acc, O + (size_t)row0 * LDP + u.pn * 128 + cw); return; }
        bf16_t* base = O + (size_t)row0 * LDP + (u.pn * 256 - 384) + cw; const int nbj = (u.pn == 8) ? 1 : 2;
        if (u.pn == 3) body<0, 0>(acc, base, (size_t)LDP, nbj); else if (u.pn == 4) body<0, 1>(acc, base, (size_t)LDP, nbj);
        else if (u.pn < 7) body<1, 1>(acc, base, (size_t)LDP, nbj); else body<2, 2>(acc, base, (size_t)LDP, nbj);
    }
};
struct EpiY {
    bf16_t* O;
    __device__ __forceinline__ void operator()(const f32x4 (&acc)[2][2][4][2], const Unit& u, int wr, int wc, int fr, int fq) const {
        const int row0 = u.pm * 256 + wr * 64 + fr, col0 = u.pn * 256 + wc * 32 + 8 * fq;
#pragma unroll
        for (int ai = 0; ai < 2; ++ai)
#pragma unroll
            for (int m = 0; m < 4; ++m) { bf16_t* rowp = O + (size_t)(row0 + ai * 128 + m * 16) * 1024 + col0;
#pragma unroll
                for (int bj = 0; bj < 2; ++bj) { const f32x4 v0 = acc[ai][bj][m][0], v1 = acc[ai][bj][m][1];
                    u32x4 w; w.x = cvt_pk_bf16(v0[0], v0[1]); w.y = cvt_pk_bf16(v0[2], v0[3]); w.z = cvt_pk_bf16(v1[0], v1[1]); w.w = cvt_pk_bf16(v1[2], v1[3]);
                    *(u32x4*)(rowp + bj * 128) = w; } }
    }
};
struct EpiDft {
    const bf16_t* P; bf16_t* Y;
    __device__ __forceinline__ void operator()(const f32x4 (&acc)[2][2][4][2], const Unit& u, int wr, int wc, int fr, int fq) const {
        const int j = u.pn; int tokbase, k1, R;
        if (j < 128) { tokbase = (j >> 3) * 2048; k1 = j & 7; R = 8; } else { const int jj = j - 128; tokbase = TP + (jj >> 4) * 4096; k1 = jj & 15; R = 16; }
        const int ch0 = wc * 32 + 8 * fq;
#pragma unroll
        for (int ai = 0; ai < 2; ++ai) {
            u32x4 gt[4][2];
#pragma unroll
            for (int m = 0; m < 4; ++m) { const int k2 = ai * 128 + wr * 64 + m * 16 + fr; const size_t tok = (size_t)(tokbase + k1 + R * k2);
#pragma unroll
                for (int bj = 0; bj < 2; ++bj) gt[m][bj] = *(const u32x4*)(P + tok * LDP + C_CG + ch0 + bj * 128); }
#pragma unroll
            for (int m = 0; m < 4; ++m) { const int k2 = ai * 128 + wr * 64 + m * 16 + fr; const size_t tok = (size_t)(tokbase + k1 + R * k2);
#pragma unroll
                for (int bj = 0; bj < 2; ++bj) { const u32x4 g = gt[m][bj];
                    const f32x4 v0 = acc[ai][bj][m][0], v1 = acc[ai][bj][m][1];
                    u32x4 w; w.x = cvt_pk_bf16(v0[0] * bf_lo(g.x), v0[1] * bf_hi(g.x)); w.y = cvt_pk_bf16(v0[2] * bf_lo(g.y), v0[3] * bf_hi(g.y));
                    w.z = cvt_pk_bf16(v1[0] * bf_lo(g.z), v1[1] * bf_hi(g.z)); w.w = cvt_pk_bf16(v1[2] * bf_lo(g.w), v1[3] * bf_hi(g.w));
                    *(u32x4*)(Y + tok * 1024 + 768 + ch0 + bj * 128) = w; } }
        }
    }
};

struct Ctx {
    const float *xp, *xs, *pre_g, *w_in, *a_ln_g, *a_ln_b, *a_w_s, *a_b_s, *b_w, *b_scale, *c_w, *w_out, *post_g;
    float* out;
    bf16_t *W1T, *WOT, *WSB, *DQ, *XB, *APT, *PROJ, *PT, *YO, *YM; float* RINV;
};

__device__ __forceinline__ void transpose_item(const float* W, int ldn, int col0, const float* ks, bf16_t* WT, int row0, int k0, LAS float* scr, int lane) {
    float tv[32];
#pragma unroll
    for (int i = 0; i < 32; ++i) { const int kk = 2 * i + (lane >> 5); tv[i] = W[(size_t)(k0 + kk) * ldn + col0 + (lane & 31)]; }
    if (ks) {
#pragma unroll
        for (int i = 0; i < 32; ++i) tv[i] *= ks[k0 + 2 * i + (lane >> 5)]; }
#pragma unroll
    for (int i = 0; i < 32; ++i) scr[(2 * i + (lane >> 5)) * 33 + (lane & 31)] = tv[i];
    asm volatile("s_waitcnt lgkmcnt(0)" ::: "memory");
    const int c = lane & 7;
#pragma unroll
    for (int j = 0; j < 4; ++j) { const int n = (lane >> 3) + 8 * j; const LAS float* s = scr + (8 * c) * 33 + n;
        u32x4 o; o.x = cvt_pk_bf16(s[0 * 33], s[1 * 33]); o.y = cvt_pk_bf16(s[2 * 33], s[3 * 33]); o.z = cvt_pk_bf16(s[4 * 33], s[5 * 33]); o.w = cvt_pk_bf16(s[6 * 33], s[7 * 33]);
        *(u32x4*)(WT + (size_t)(row0 + n) * 1024 + k0 + 8 * c) = o; }
    asm volatile("s_waitcnt lgkmcnt(0)" ::: "memory");
}

template <int GD, int NP>
__device__ __forceinline__ void fold_compute(const Ctx& C, int l, int k0, int srccol, LAS float* Gm  , LAS float* Ws  , int dst0, int dst1) {
    constexpr int GS = NP + 4, J = NP / 8;
    const int tid = opaque_tid();
    { float wv[64 * GD / 512], pgv[64 * GD / 512];
#pragma unroll
      for (int j = 0; j < 64 * GD / 512; ++j) { const int idx = tid + 512 * j; const int kk = idx / GD, c = idx - kk * GD;
          wv[j] = C.w_in[(size_t)l * 1024 * INW + (size_t)(k0 + kk) * INW + srccol + c]; pgv[j] = C.pre_g[l * 1024 + k0 + kk]; }
#pragma unroll
      for (int j = 0; j < 64 * GD / 512; ++j) { const int idx = tid + 512 * j; const int kk = idx / GD, c = idx - kk * GD; Ws[kk * (GD + 1) + c] = wv[j] * pgv[j]; } }
    __syncthreads();
    const int kk = tid & 63, wv = tid >> 6, n0 = wv * J;
    float acc[J];
#pragma unroll
    for (int j = 0; j < J; ++j) acc[j] = 0.f;
#pragma unroll 4
    for (int c = 0; c < GD; ++c) { const float w = Ws[kk * (GD + 1) + c];
#pragma unroll
        for (int jj = 0; jj < J / 4; ++jj) { const f32x4 g4 = *(const LAS f32x4*)(Gm + c * GS + n0 + 4 * jj);
            acc[4 * jj + 0] += w * g4[0]; acc[4 * jj + 1] += w * g4[1]; acc[4 * jj + 2] += w * g4[2]; acc[4 * jj + 3] += w * g4[3]; } }
    bf16_t* WT = C.W1T + (size_t)l * N1PAD * 1024;
#pragma unroll
    for (int j = 0; j < J; ++j) { const int n = n0 + j; const int row = (NP == 128 && n >= 64) ? (dst1 + n - 64) : (dst0 + n);
        WT[(size_t)row * 1024 + k0 + kk] = (bf16_t)(cvt_pk_bf16(acc[j], 0.f) & 0xffffu); }
    __syncthreads();
}
__device__ __forceinline__ void fold_item(const Ctx& C, int it, LAS unsigned char* lds) {
    const int l = it >> 7, r = it & 127, grp = r >> 4, kb = r & 15, k0 = kb * 64, tid = opaque_tid();
    LAS float* Gm = (LAS float*)lds;
    LAS float* Ws = (LAS float*)(lds + 40960);
    LAS float* Wc = (LAS float*)(lds + 69632);
    LAS float* tb = (LAS float*)(lds + 90112);
    if (grp < 4) {
        const int g = grp;
        { float bw[18], bs[18];
#pragma unroll
          for (int j = 0; j < 18; ++j) { const int idx = tid + 512 * j; const int c = idx / 96, n = idx - c * 96; bw[j] = C.b_w[((size_t)(l * 4 + g) * 96 + c) * 96 + n]; bs[j] = C.b_scale[l * 384 + g * 96 + n]; }
#pragma unroll
          for (int j = 0; j < 18; ++j) { const int idx = tid + 512 * j; const int c = idx / 96, n = idx - c * 96; Gm[c * 100 + n] = bw[j] * bs[j]; } }
        fold_compute<96, 96>(C, l, k0, 1152 + g * 96, Gm, Ws, R_B + g * 96, 0);
    } else {
        const int g = grp - 4;
        if (tid < 64) { float s, c; sincospif((float)tid * (1.0f / 32.0f), &s, &c); tb[tid] = c; tb[64 + tid] = s; }
        { float cw[8];
#pragma unroll
          for (int j = 0; j < 8; ++j) cw[j] = C.c_w[(size_t)(l * 4 + g) * 4096 + tid + 512 * j];
#pragma unroll
          for (int j = 0; j < 8; ++j) { const int idx = tid + 512 * j; Wc[(idx >> 6) * 65 + (idx & 63)] = cw[j]; } }
        __syncthreads();
        for (int idx = tid; idx < 4096; idx += 512) { const int c = idx >> 6, d = idx & 63; float gc = 0.f, gs = 0.f;
#pragma unroll 16
            for (int m = 0; m < 64; ++m) { const float w = Wc[m * 65 + d]; const int ph = (m * c) & 63; gc += tb[ph] * w; gs += tb[64 + ph] * w; }
            Gm[c * 132 + d] = gc; Gm[c * 132 + 64 + d] = gs; }
        fold_compute<64, 128>(C, l, k0, 1920 + g * 64, Gm, Ws, R_PC + g * 64, R_PS + g * 64);
    }
}
__device__ __forceinline__ const float* xrow_ptr(const Ctx& C, int t) { return t < TP ? C.xp + (size_t)t * 1024 : C.xs + (size_t)(t - TP) * 1024; }

__device__ __forceinline__ void weight_prep(const Ctx& C, LAS unsigned char* lds, int l, int vb, int NB) {
    const int tid = opaque_tid(), lane = tid & 63, wave = tid >> 6;
    for (int it = vb; it < 128; it += NB) fold_item(C, l * 128 + it, lds);
    const int gw = vb * 8 + wave, NGW = NB * 8;
    LAS float* scr = (LAS float*)(lds + wave * 8704);
    for (int r = gw; r < 1408; r += NGW) {
        if (r < 896) { const int nb = r >> 4, kb = r & 15, dst = nb * 32;
            int src;
            if (dst < 768) { const int t = dst >> 8, r = dst & 255; src = (r < 128) ? 128 * t + r : 768 + 128 * t + (r - 128); }
            else if (dst < 1152) src = dst - 768 + 384; else if (dst < 1536) src = dst - 1152 + 1536; else src = dst - 1536 + 2176;
            transpose_item(C.w_in + (size_t)l * 1024 * INW, INW, src, C.pre_g + l * 1024, C.W1T + (size_t)l * N1PAD * 1024, dst, kb * 64, scr, lane);
        } else { const int r2 = r - 896; const int nb = r2 >> 4, kb = r2 & 15;
            transpose_item(C.w_out + (size_t)l * 1024 * 1024, 1024, nb * 32, nullptr, C.WOT + (size_t)l * 1024 * 1024, nb * 32, kb * 64, scr, lane); }
    }
    const int gt = vb * 512 + tid, NGT = NB * 512;
    for (int r = gt; r < 128 * 128; r += NGT) *(u32x4*)(C.W1T + (size_t)l * N1PAD * 1024 + (size_t)2176 * 1024 + (size_t)r * 8) = (u32x4){0u, 0u, 0u, 0u};
    for (int i = gt; i < 4 * 128 * 128 / 2; i += NGT) { const size_t e = (size_t)l * 4 * 128 * 128 + 2 * (size_t)i; const f32x2 v = *(const f32x2*)(C.a_w_s + e); *(unsigned*)(C.WSB + e) = cvt_pk_bf16(v.x, v.y); }
}
__device__ __forceinline__ void p0_prologue(const Ctx& C, LAS unsigned char* lds) {
#pragma unroll 1
    for (int l = 0; l < 2; ++l) weight_prep(C, lds, l, (blockIdx.x + 128 * l) % gridDim.x, gridDim.x);
    const int tid = opaque_tid(), lane = tid & 63, wave = tid >> 6, G = gridDim.x, bid = blockIdx.x;
    const int gw = bid * 8 + wave, NGW = G * 8;
    const int gt = bid * 512 + tid, NGT = G * 512;
    for (int i = gt; i < 256 * 512; i += NGT) { const int k2 = i >> 9, jj = i & 511, s2 = jj & 255; const int ph = (k2 * s2) & 255; float s, c; sincospif((float)ph * (1.0f / 128.0f), &s, &c);
        C.DQ[i] = (bf16_t)(cvt_pk_bf16(jj < 256 ? c : -s, 0.f) & 0xffffu); }
    for (int t4 = gw; t4 < T_TOK / 4; t4 += NGW) {
        const f32x4* xr = (const f32x4*)xrow_ptr(C, 4 * t4) + lane; f32x4 v[4][4]; float s[4];
#pragma unroll
        for (int r = 0; r < 4; ++r)
#pragma unroll
            for (int j = 0; j < 4; ++j) v[r][j] = xr[256 * r + 64 * j];
#pragma unroll
        for (int r = 0; r < 4; ++r) { s[r] = 0.f;
#pragma unroll
            for (int j = 0; j < 4; ++j) s[r] += (v[r][j].x * v[r][j].x + v[r][j].y * v[r][j].y) + (v[r][j].z * v[r][j].z + v[r][j].w * v[r][j].w); }
#pragma unroll
        for (int o = 1; o < 64; o <<= 1) {
#pragma unroll
            for (int r = 0; r < 4; ++r) s[r] += __shfl_xor(s[r], o); }
        u32x2* op = (u32x2*)(C.XB + (size_t)(4 * t4) * 1024) + lane;
#pragma unroll
        for (int r = 0; r < 4; ++r) { const float ms = s[r] * (1.0f / 1024.0f) + EPS; const float rs = rsqrtf(ms); if (lane == 0) C.RINV[4 * t4 + r] = ms * rs;
#pragma unroll
            for (int j = 0; j < 4; ++j) { u32x2 w; w.x = cvt_pk_bf16(v[r][j].x * rs, v[r][j].y * rs); w.y = cvt_pk_bf16(v[r][j].z * rs, v[r][j].w * rs); op[256 * r + 64 * j] = w; } }
    }
}

constexpr int VSTR = 136;
struct VPre { u32x4 p[3]; };
struct UGPre { u32x2 u[6]; };
__device__ __forceinline__ VPre mixer_a_load_v(const Ctx& C, int unit, int tid) {
    const int c = unit >> 2, h = unit & 3, q = tid >> 2, part = tid & 3;
    const bf16_t* src = C.PROJ + (size_t)(c * 128 + q) * LDP + C_V + h * 96 + part * 24;
    VPre r;
#pragma unroll
    for (int i = 0; i < 3; ++i) r.p[i] = *(const u32x4*)(src + 8 * i);
    return r;
}
__device__ __forceinline__ UGPre mixer_a_load_ug(const Ctx& C, int unit, int w, int fr, int fq) {
    const int c = unit >> 2, h = unit & 3; const size_t tok = (size_t)(c * 128 + 16 * w + fr);
    UGPre r;
#pragma unroll
    for (int nb = 0; nb < 6; ++nb) { const int dc = h * 96 + nb * 16 + 4 * fq; r.u[nb] = *(const u32x2*)(C.PROJ + tok * LDP + C_U + dc); }
    return r;
}
__device__ __forceinline__ void mixer_a_units(const Ctx& C, int l, LAS unsigned char* lds) {
    const int tid = opaque_tid(), lane = tid & 63, w = tid >> 6, fr = lane & 15, fq = lane >> 4, G = gridDim.x;
    LAS bf16_t* vt = (LAS bf16_t*)lds;
    int unit = blockIdx.x;
    if (unit >= 1536) return;
    const int q = tid >> 2, part = tid & 3, d0 = part * 24, p = 16 * w + fr;
    VPre vp = mixer_a_load_v(C, unit, tid);
    UGPre ugn = mixer_a_load_ug(C, unit, w, fr, fq);
    int hcur = -1; float lg[24], lb[24], bias = 0.f; bf16x8 af[4];
    for (; unit < 1536; unit += G) {
        const int c = unit >> 2, h = unit & 3, t0 = c * 128;
        if (h != hcur) {
            hcur = h;
#pragma unroll
            for (int i = 0; i < 24; i += 4) { const f32x4 g4 = *(const f32x4*)(C.a_ln_g + l * 384 + h * 96 + d0 + i), b4 = *(const f32x4*)(C.a_ln_b + l * 384 + h * 96 + d0 + i);
                lg[i] = g4[0]; lg[i + 1] = g4[1]; lg[i + 2] = g4[2]; lg[i + 3] = g4[3]; lb[i] = b4[0]; lb[i + 1] = b4[1]; lb[i + 2] = b4[2]; lb[i + 3] = b4[3]; }
            const bf16_t* wsrow = C.WSB + ((size_t)(l * 4 + h) * 128 + p) * 128 + 8 * fq;
#pragma unroll
            for (int ks = 0; ks < 4; ++ks) af[ks] = *(const bf16x8*)(wsrow + ks * 32);
            bias = C.a_b_s[(l * 4 + h) * 128 + p];
        }
        {
            float v[24];
#pragma unroll
            for (int i = 0; i < 3; ++i) { const u32x4 pk = vp.p[i];
                v[8 * i + 0] = bf_lo(pk.x); v[8 * i + 1] = bf_hi(pk.x); v[8 * i + 2] = bf_lo(pk.y); v[8 * i + 3] = bf_hi(pk.y);
                v[8 * i + 4] = bf_lo(pk.z); v[8 * i + 5] = bf_hi(pk.z); v[8 * i + 6] = bf_lo(pk.w); v[8 * i + 7] = bf_hi(pk.w); }
            float s = 0.f;
#pragma unroll
            for (int i = 0; i < 24; ++i) s += v[i];
            s += __shfl_xor(s, 1); s += __shfl_xor(s, 2);
            const float mean = s * (1.0f / 96.0f); float q2 = 0.f;
#pragma unroll
            for (int i = 0; i < 24; ++i) { v[i] -= mean; q2 += v[i] * v[i]; }
            q2 += __shfl_xor(q2, 1); q2 += __shfl_xor(q2, 2);
            const float rstd = rsqrtf(q2 * (1.0f / 96.0f) + EPS);
            const int qs = q ^ (part << 4);
#pragma unroll
            for (int i = 0; i < 24; ++i) { const float o = v[i] * rstd * lg[i] + lb[i]; vt[(d0 + i) * VSTR + qs] = (bf16_t)(cvt_pk_bf16(o, 0.f) & 0xffffu); }
        }
        const UGPre ug = ugn;
        __syncthreads();
        if (unit + G < 1536) { vp = mixer_a_load_v(C, unit + G, tid); ugn = mixer_a_load_ug(C, unit + G, w, fr, fq); }
        f32x4 acc[6];
#pragma unroll
        for (int nb = 0; nb < 6; ++nb) { acc[nb] = (f32x4){0.f, 0.f, 0.f, 0.f}; const int d = nb * 16 + fr, pr2 = 2 * (d / 24);
#pragma unroll
            for (int ks = 0; ks < 4; ++ks) { const bf16x8 bfr = *(const LAS bf16x8*)(vt + d * VSTR + (((ks * 4 + fq) ^ pr2) << 3));
                acc[nb] = __builtin_amdgcn_mfma_f32_16x16x32_bf16(bfr, af[ks], acc[nb], 0, 0, 0); } }
        const size_t tok = (size_t)(t0 + p);
#pragma unroll
        for (int nb = 0; nb < 6; ++nb) { const int dc = h * 96 + nb * 16 + 4 * fq;
            u32x2 o; o.x = cvt_pk_bf16((acc[nb][0] + bias) * bf_lo(ug.u[nb].x), (acc[nb][1] + bias) * bf_hi(ug.u[nb].x));
            o.y = cvt_pk_bf16((acc[nb][2] + bias) * bf_lo(ug.u[nb].y), (acc[nb][3] + bias) * bf_hi(ug.u[nb].y));
            *(u32x2*)(C.YM + tok * 1024 + dc) = o; }
        __syncthreads();
    }
}

__device__ __forceinline__ void acc8(float (&s)[8], const u32x4 p, float m) {
    s[0] += m * bf_lo(p.x); s[1] += m * bf_hi(p.x); s[2] += m * bf_lo(p.y); s[3] += m * bf_hi(p.y); s[4] += m * bf_lo(p.z); s[5] += m * bf_hi(p.z); s[6] += m * bf_lo(p.w); s[7] += m * bf_hi(p.w);
}
__device__ __forceinline__ void mixer_b_run(const Ctx& C, int item) {
    const int run = item / 48, cb = item - run * 48, g = cb / 12, half = 1 << g, t0 = run * 32;
    int S, pos0;
    if (t0 < TP) { S = 2048; pos0 = t0 & 2047; } else { S = 4096; pos0 = (t0 - TP) & 4095; }
    const bf16_t* zb = C.PROJ + (size_t)(t0 - pos0) * LDP + C_B + cb * 8;
    const bf16_t* gb = C.PROJ + (size_t)(t0 - pos0) * LDP + C_BG + cb * 8;
    bf16_t* yb = C.YM + (size_t)(t0 - pos0) * 1024 + 384 + cb * 8;
    float s[8];
#pragma unroll
    for (int i = 0; i < 8; ++i) s[i] = 0.f;
    int cnt = 0;
#pragma unroll
    for (int d = -8; d < 8; ++d) { const int tau = pos0 + d; const bool ok = (d >= -half) && (d < half) && (tau >= 0) && (tau < S);
        const int tc = min(max(tau, 0), S - 1); const u32x4 p = *(const u32x4*)(zb + (size_t)tc * LDP); acc8(s, p, ok ? 1.f : 0.f); cnt += ok ? 1 : 0; }
#pragma unroll 4
    for (int i = 0; i < 32; ++i) {
        const int pos = pos0 + i, lead = pos + half, trail = pos - half;
        const u32x4 zc = *(const u32x4*)(zb + (size_t)pos * LDP), gt = *(const u32x4*)(gb + (size_t)pos * LDP);
        const u32x4 pl = *(const u32x4*)(zb + (size_t)min(lead, S - 1) * LDP), ptr = *(const u32x4*)(zb + (size_t)max(trail, 0) * LDP);
        const float inv = 1.0f / (float)cnt;
        u32x4 o;
        o.x = cvt_pk_bf16((s[0] * inv - bf_lo(zc.x)) * bf_lo(gt.x), (s[1] * inv - bf_hi(zc.x)) * bf_hi(gt.x));
        o.y = cvt_pk_bf16((s[2] * inv - bf_lo(zc.y)) * bf_lo(gt.y), (s[3] * inv - bf_hi(zc.y)) * bf_hi(gt.y));
        o.z = cvt_pk_bf16((s[4] * inv - bf_lo(zc.z)) * bf_lo(gt.z), (s[5] * inv - bf_hi(zc.z)) * bf_hi(gt.z));
        o.w = cvt_pk_bf16((s[6] * inv - bf_lo(zc.w)) * bf_lo(gt.w), (s[7] * inv - bf_hi(zc.w)) * bf_hi(gt.w));
        *(u32x4*)(yb + (size_t)pos * 1024) = o;
        const bool addl = lead < S, subt = trail >= 0;
        acc8(s, pl, addl ? 1.f : 0.f); acc8(s, ptr, subt ? -1.f : 0.f); cnt += (addl ? 1 : 0) - (subt ? 1 : 0);
    }
}

template <int NS> struct VecN;
template <> struct VecN<8> { typedef u32x4 T; };
template <> struct VecN<4> { typedef u32x2 T; };
__device__ __forceinline__ void unpackN(const u32x4 p, float (&f)[8]) { f[0] = bf_lo(p.x); f[1] = bf_hi(p.x); f[2] = bf_lo(p.y); f[3] = bf_hi(p.y); f[4] = bf_lo(p.z); f[5] = bf_hi(p.z); f[6] = bf_lo(p.w); f[7] = bf_hi(p.w); }
__device__ __forceinline__ void unpackN(const u32x2 p, float (&f)[4]) { f[0] = bf_lo(p.x); f[1] = bf_hi(p.x); f[2] = bf_lo(p.y); f[3] = bf_hi(p.y); }
__device__ __forceinline__ u32x4 packN(const float (&f)[8]) { u32x4 w; w.x = cvt_pk_bf16(f[0], f[1]); w.y = cvt_pk_bf16(f[2], f[3]); w.z = cvt_pk_bf16(f[4], f[5]); w.w = cvt_pk_bf16(f[6], f[7]); return w; }
__device__ __forceinline__ u32x2 packN(const float (&f)[4]) { u32x2 w; w.x = cvt_pk_bf16(f[0], f[1]); w.y = cvt_pk_bf16(f[2], f[3]); return w; }
__device__ __forceinline__ void cmul(float& r, float& i, float cr, float ci) { const float nr = r * cr - i * ci, ni = r * ci + i * cr; r = nr; i = ni; }
template <int R, int NS>
__device__ __forceinline__ void dft1_item(const Ctx& C, int seqtok0, int S, int unit0, int ch, int sb, int k10) {
    typedef typename VecN<NS>::T V;
    constexpr int NH = NS / 2;
    f32x2 a2[R][NH], b2[R][NH];
    {
        V pc[R], ps[R];
        const bf16_t* pcrow = C.PT + (size_t)ch * T_TOK + seqtok0 + NS * sb; const bf16_t* psrow = pcrow + (size_t)256 * T_TOK;
#pragma unroll
        for (int s1 = 0; s1 < R; ++s1) { pc[s1] = *(const V*)(pcrow + 256 * s1); ps[s1] = *(const V*)(psrow + 256 * s1); }
#pragma unroll
        for (int s1 = 0; s1 < R; ++s1) { float a[NS], b[NS]; unpackN(pc[s1], a); unpackN(ps[s1], b);
#pragma unroll
            for (int jj = 0; jj < NH; ++jj) { a2[s1][jj] = (f32x2){a[2 * jj], a[2 * jj + 1]}; b2[s1][jj] = (f32x2){b[2 * jj], b[2 * jj + 1]}; } }
    }
    const float scale = rsqrtf(64.0f * (float)S);
    float w1i, w1r, wki, wkr, m0i, m0r, twi, twr, e1i, e1r, sti, str_;
    sincospif(2.0f / (float)R, &w1i, &w1r); sincospif((float)k10 * (2.0f / (float)R), &wki, &wkr);
    const int s20 = NS * sb;
    sincospif((float)s20 * (2.0f / (float)S), &m0i, &m0r); sincospif((float)((k10 * s20) & (S - 1)) * (2.0f / (float)S), &twi, &twr); twi *= scale; twr *= scale;
    sincospif(2.0f / (float)S, &e1i, &e1r); sincospif((float)k10 * (2.0f / (float)S), &sti, &str_);
#pragma unroll 1
    for (int k1 = k10; k1 < k10 + 8; ++k1) {
        float wr = 1.f, wi = 0.f; f32x2 are[NH], aim[NH];
#pragma unroll
        for (int jj = 0; jj < NH; ++jj) { are[jj] = (f32x2){0.f, 0.f}; aim[jj] = (f32x2){0.f, 0.f}; }
#pragma unroll
        for (int s1 = 0; s1 < R; ++s1) {
#pragma unroll
            for (int jj = 0; jj < NH; ++jj) { are[jj] += a2[s1][jj] * wr - b2[s1][jj] * wi; aim[jj] += b2[s1][jj] * wr + a2[s1][jj] * wi; }
            cmul(wr, wi, wkr, wki);
        }
        float tc = twr, ts = twi, ore[NS], oim[NS];
#pragma unroll
        for (int jj = 0; jj < NH; ++jj) {
            ore[2 * jj] = are[jj].x * tc - aim[jj].x * ts; oim[2 * jj] = are[jj].x * ts + aim[jj].x * tc; cmul(tc, ts, str_, sti);
            ore[2 * jj + 1] = are[jj].y * tc - aim[jj].y * ts; oim[2 * jj + 1] = are[jj].y * ts + aim[jj].y * tc; cmul(tc, ts, str_, sti); }
        bf16_t* ob = C.APT + ((size_t)(unit0 + k1) * 256 + ch) * 512 + s20;
        *(V*)ob = packN(ore); *(V*)(ob + 256) = packN(oim);
        cmul(wkr, wki, w1r, w1i); cmul(twr, twi, m0r, m0i); cmul(str_, sti, e1r, e1i);
    }
}

__device__ __forceinline__ void p2_mixers_ab(const Ctx& C, int l, LAS unsigned char* lds) {
    const int G = gridDim.x, bid = blockIdx.x;
    mixer_a_units(C, l, lds);
    const int gt = bid * 512 + opaque_tid(), NGT = G * 512;
    for (int it = gt; it < 1536 * 48; it += NGT) mixer_b_run(C, it);
}
__device__ __forceinline__ void p2_dft1(const Ctx& C) {
    const int G = gridDim.x, bid = blockIdx.x, tid = opaque_tid();
    const int gt = bid * 512 + tid, NGT = G * 512;
    for (int it = gt; it < 131072; it += NGT) { const int sb = it & 63, ch = (it >> 6) & 255, kh = (it >> 14) & 1, b = it >> 15; dft1_item<16, 4>(C, TP + b * 4096, 4096, 128 + b * 16, ch, sb, 8 * kh); }
    for (int it = gt; it < 131072; it += NGT) { const int sb = it & 31, ch = (it >> 5) & 255, b = it >> 13; dft1_item<8, 8>(C, b * 2048, 2048, b * 8, ch, sb, 0); }
}

__device__ __forceinline__ void unpack8(const u32x4 p, float* f) { f[0] = bf_lo(p.x); f[1] = bf_hi(p.x); f[2] = bf_lo(p.y); f[3] = bf_hi(p.y); f[4] = bf_lo(p.z); f[5] = bf_hi(p.z); f[6] = bf_lo(p.w); f[7] = bf_hi(p.w); }
template <int L>
__device__ __forceinline__ void p5_residual(const Ctx& C) {
    const int tid = opaque_tid(), lane = tid & 63, wave = tid >> 6, G = gridDim.x, bid = blockIdx.x;
    const int gw = bid * 8 + wave, NGW = G * 8;
    const float* pg = C.post_g + L * 1024;
    f32x4 gv[2][2];
#pragma unroll
    for (int j = 0; j < 2; ++j) { gv[j][0] = *(const f32x4*)(pg + 8 * lane + 512 * j); gv[j][1] = *(const f32x4*)(pg + 8 * lane + 512 * j + 4); }
    for (int t2 = gw; t2 < T_TOK / 2; t2 += NGW) {
        const int t = 2 * t2;
        u32x4 yp[2][2]; float x[2][16];
#pragma unroll
        for (int r = 0; r < 2; ++r)
#pragma unroll
            for (int j = 0; j < 2; ++j) yp[r][j] = *(const u32x4*)(C.YO + (size_t)(t + r) * 1024 + 8 * lane + 512 * j);
        {
            u32x4 xp[2][2]; float ri[2];
#pragma unroll
            for (int r = 0; r < 2; ++r) { ri[r] = C.RINV[t + r];
#pragma unroll
                for (int j = 0; j < 2; ++j) xp[r][j] = *(const u32x4*)(C.XB + (size_t)(t + r) * 1024 + 8 * lane + 512 * j); }
#pragma unroll
            for (int r = 0; r < 2; ++r)
#pragma unroll
                for (int j = 0; j < 2; ++j) { unpack8(xp[r][j], &x[r][8 * j]);
#pragma unroll
                    for (int i = 0; i < 8; ++i) x[r][8 * j + i] *= ri[r]; }
        }
        float y[2][16], ss[2];
#pragma unroll
        for (int r = 0; r < 2; ++r) { ss[r] = 0.f;
#pragma unroll
            for (int j = 0; j < 2; ++j) unpack8(yp[r][j], &y[r][8 * j]);
#pragma unroll
            for (int i = 0; i < 16; ++i) ss[r] += y[r][i] * y[r][i]; }
#pragma unroll
        for (int o = 1; o < 64; o <<= 1) { ss[0] += __shfl_xor(ss[0], o); ss[1] += __shfl_xor(ss[1], o); }
        float ss2[2];
#pragma unroll
        for (int r = 0; r < 2; ++r) { const float rr = rsqrtf(ss[r] * (1.0f / 1024.0f) + EPS); ss2[r] = 0.f;
#pragma unroll
            for (int j = 0; j < 2; ++j)
#pragma unroll
                for (int i = 0; i < 8; ++i) { const float gg = (i < 4) ? gv[j][0][i] : gv[j][1][i - 4]; const float o = x[r][8 * j + i] + y[r][8 * j + i] * rr * gg; x[r][8 * j + i] = o; ss2[r] += o * o; } }
        if (L == 0) {
#pragma unroll
            for (int o = 1; o < 64; o <<= 1) { ss2[0] += __shfl_xor(ss2[0], o); ss2[1] += __shfl_xor(ss2[1], o); }
#pragma unroll
            for (int r = 0; r < 2; ++r) { const float ms = ss2[r] * (1.0f / 1024.0f) + EPS; const float r2 = rsqrtf(ms);
                if (lane == 0) C.RINV[t + r] = ms * r2;
#pragma unroll
                for (int j = 0; j < 2; ++j) { u32x4 w; w.x = cvt_pk_bf16(x[r][8 * j + 0] * r2, x[r][8 * j + 1] * r2); w.y = cvt_pk_bf16(x[r][8 * j + 2] * r2, x[r][8 * j + 3] * r2);
                    w.z = cvt_pk_bf16(x[r][8 * j + 4] * r2, x[r][8 * j + 5] * r2); w.w = cvt_pk_bf16(x[r][8 * j + 6] * r2, x[r][8 * j + 7] * r2);
                    *(u32x4*)(C.XB + (size_t)(t + r) * 1024 + 8 * lane + 512 * j) = w; } }
        } else {
#pragma unroll
            for (int r = 0; r < 2; ++r) { float* orow = C.out + (size_t)(t + r) * 1024;
#pragma unroll
                for (int j = 0; j < 2; ++j) { *(f32x4*)(orow + 8 * lane + 512 * j) = (f32x4){x[r][8 * j + 0], x[r][8 * j + 1], x[r][8 * j + 2], x[r][8 * j + 3]};
                    *(f32x4*)(orow + 8 * lane + 512 * j + 4) = (f32x4){x[r][8 * j + 4], x[r][8 * j + 5], x[r][8 * j + 6], x[r][8 * j + 7]}; } }
        }
    }
}

#define XB_TMO      128
#define XB_XCNT(j)  (256  + 64 * (j))
#define XB_XSUB(j)  (1280 + 64 * (j))
#define XB_XGEN(j)  (2304 + 64 * (j))
#define XB_TOP      3328
#define XB_TOPGEN   3392
#define XCD_BAR_WORDS 3456
#define XB_SPIN_CAP (1u << 18)
__device__ __forceinline__ unsigned xb_ld(unsigned* p)              { return __hip_atomic_load(p, __ATOMIC_RELAXED, __HIP_MEMORY_SCOPE_AGENT); }
__device__ __forceinline__ unsigned xb_add(unsigned* p, unsigned v) { return __hip_atomic_fetch_add(p, v, __ATOMIC_RELAXED, __HIP_MEMORY_SCOPE_AGENT); }
__device__ __forceinline__ unsigned xb_xcc_id() { return (unsigned)__builtin_amdgcn_s_getreg((3 << 11) | 20) & 0xFu; }
#define XB_SPIN(cond, bar) do { unsigned _sp = 0; while (cond) { __builtin_amdgcn_s_sleep(1); \
    if ((++_sp & 255u) == 0u) { if (xb_ld(&(bar)[XB_TMO])) break; if (_sp > XB_SPIN_CAP) { atomicAdd(&(bar)[XB_TMO], 1u); break; } } } } while (0)
struct XcdBarrier { unsigned* bar; unsigned x; volatile LAS unsigned* st; };
__device__ __forceinline__ XcdBarrier xcd_barrier_post(unsigned* bar, volatile LAS unsigned* st) {
    XcdBarrier b; b.bar = bar; b.x = xb_xcc_id(); b.st = st;
    if (threadIdx.x == 0) (void)xb_add(&bar[XB_XCNT(b.x)], 1u);
    return b;
}
__device__ __forceinline__ void xcd_barrier_complete(unsigned* bar, unsigned x, unsigned& nloc, unsigned& nx) {
    const unsigned G = gridDim.x * gridDim.y * gridDim.z;
    unsigned sum, cnt, mine, sp = 0u;
    for (;;) {
        sum = 0u; cnt = 0u; mine = 0u;
#pragma unroll
        for (unsigned j = 0; j < 16; ++j) { const unsigned c = xb_ld(&bar[XB_XCNT(j)]); sum += c; cnt += (c > 0u) ? 1u : 0u; mine = (j == x) ? c : mine; }
        if (sum == G) break;
        __builtin_amdgcn_s_sleep(1);
        if ((++sp & 255u) == 0u) { if (xb_ld(&bar[XB_TMO])) break; if (sp > XB_SPIN_CAP) { atomicAdd(&bar[XB_TMO], 1u); break; } }
    }
    nloc = mine > 0u ? mine : 1u; nx = cnt > 0u ? cnt : 1u;
}
__device__ __forceinline__ void xcd_barrier(const XcdBarrier& b) {
    asm volatile("s_waitcnt vmcnt(0)" ::: "memory");
    __syncthreads();
    if (threadIdx.x == 0) {
        unsigned* bar = b.bar;
        __builtin_amdgcn_s_waitcnt(0);
        unsigned nloc = b.st[0], nx = b.st[1];
        if (nloc == 0u) { xcd_barrier_complete(bar, b.x, nloc, nx); b.st[0] = nloc; b.st[1] = nx; }
        const unsigned old = xb_add(&bar[XB_XSUB(b.x)], 1u);
        const unsigned gen = old / nloc;
        if (old + 1u == (gen + 1u) * nloc) {
            __builtin_amdgcn_fence(__ATOMIC_RELEASE, "agent");
            asm volatile("s_waitcnt vmcnt(0)" ::: "memory");
            const unsigned og = xb_add(&bar[XB_TOP], 1u);
            const unsigned tg = og / nx;
            if (og + 1u == (tg + 1u) * nx) xb_add(&bar[XB_TOPGEN], 1u);
            else XB_SPIN(xb_ld(&bar[XB_TOPGEN]) == tg, bar);
            __builtin_amdgcn_fence(__ATOMIC_ACQUIRE, "agent");
            xb_add(&bar[XB_XGEN(b.x)], 1u);
            asm volatile("s_waitcnt vmcnt(0)" ::: "memory");
        } else {
            XB_SPIN(xb_ld(&bar[XB_XGEN(b.x)]) == gen, bar);
            __builtin_amdgcn_fence(__ATOMIC_ACQUIRE, "agent");
            asm volatile("s_waitcnt vmcnt(0)" ::: "memory");
        }
    }
    __syncthreads();
}

__global__ void __launch_bounds__(512, 2) fwd_kernel(Args a) {
    extern __shared__ __attribute__((aligned(16))) unsigned char shm[];
    LAS unsigned char* lds = (LAS unsigned char*)shm;
    cg::grid_group grid = cg::this_grid();
    Ctx C;
    C.xp = a.in[0]; C.xs = a.in[1]; C.pre_g = a.in[2]; C.w_in = a.in[3]; C.a_ln_g = a.in[4]; C.a_ln_b = a.in[5]; C.a_w_s = a.in[6]; C.a_b_s = a.in[7];
    C.b_w = a.in[8]; C.b_scale = a.in[9]; C.c_w = a.in[10]; C.w_out = a.in[11]; C.post_g = a.in[12];
    C.out = a.out;
    C.W1T = (bf16_t*)(a.ws + OFF_W1T); C.WOT = (bf16_t*)(a.ws + OFF_WOT); C.WSB = (bf16_t*)(a.ws + OFF_WSB); C.DQ = (bf16_t*)(a.ws + OFF_DQ);
    C.XB = (bf16_t*)(a.ws + OFF_XB); C.APT = (bf16_t*)a.out;   C.RINV = (float*)(a.ws + OFF_RINV); C.PROJ = (bf16_t*)(a.ws + OFF_PROJ); C.PT = (bf16_t*)(a.ws + OFF_PT); C.YO = (bf16_t*)(a.ws + OFF_PROJ); C.YM = (bf16_t*)(a.ws + OFF_YM);
    const int G = gridDim.x, bid = blockIdx.x;
    volatile LAS unsigned* bst = (volatile LAS unsigned*)(lds + 131072);
    if (threadIdx.x < 4) bst[threadIdx.x] = 0u;
    __syncthreads();
    const XcdBarrier xbar = xcd_barrier_post((unsigned*)(a.ws + OFF_BAR), bst);
    for (int pi = a.ph_lo; pi < a.ph_hi; ++pi) {
        const int ph = (PROBE_REPEAT >= 0 && pi > PROBE_REPEAT) ? pi - 1 : pi;
        if (ph == 0) p0_prologue(C, lds);
        else {
            const int l = (ph - 1) / 5, sub = (ph - 1) % 5;
            if (sub == 0) { unsigned* cnt = (unsigned*)(a.ws + OFF_BAR) + 4096 + 2048 * l;     pg8::SchedG1 S; S.init(C.XB, C.W1T + (size_t)l * N1PAD * 1024, G, bid); S.cnt = cnt; S.x = xbar.x; S.nwav = 8u * bst[0]; S.xsub = cnt + 128; const unsigned nx = bst[1]; EpiProj E{C.PROJ, C.PT}; pg8::gemm_phase<GA, GS>(lds, 1024, S, E);
                (void)nx; xcd_barrier(xbar); p2_mixers_ab(C, l, lds); }
            else if (sub == 1) p2_dft1(C);
            else if (sub == 2) { pg8::Gemm g{C.DQ, C.APT, 256, 192 * 256, 512}; pg8::SchedPlain S; S.init(g, G, bid); EpiDft E{C.PROJ, C.YM}; pg8::gemm_phase<false, GS>(lds, 512, S, E); }
            else if (sub == 3) { pg8::Gemm g{C.YM, C.WOT + (size_t)l * 1024 * 1024, T_TOK, 1024, 1024}; pg8::SchedPlain S; S.init(g, G, bid); EpiY E{C.YO}; pg8::gemm_phase<GA, GS>(lds, 1024, S, E); }
            else { if (l == 0) p5_residual<0>(C); else p5_residual<1>(C); }
        }
        if (pi + 1 < a.ph_hi) { if (a.ph_hi > 1000) grid.sync();   xcd_barrier(xbar); }
    }
}

extern "C" void kernel_launch(void* const* d_in, const int* in_sizes, int n_in, void* d_out, int out_size, void* d_ws, size_t ws_size, hipStream_t stream) {
    static int grid = 0;
    if (grid == 0) {
        if (n_in != 13 || ws_size < WS_END) { fprintf(stderr, "kernel_launch: need 13 inputs and >= %zu bytes of workspace; got n_in %d, ws %zu\n", (size_t)WS_END, n_in, ws_size); grid = -1; return; }
        int dev = 0, cus = 0, per_cu = 0;
        hipGetDevice(&dev); hipDeviceGetAttribute(&cus, hipDeviceAttributeMultiprocessorCount, dev);
        if (hipFuncSetAttribute((const void*)fwd_kernel, hipFuncAttributeMaxDynamicSharedMemorySize, LDS_BYTES) != hipSuccess) { fprintf(stderr, "kernel_launch: hipFuncSetAttribute failed\n"); grid = -1; return; }
        if (hipOccupancyMaxActiveBlocksPerMultiprocessor(&per_cu, (const void*)fwd_kernel, 512, LDS_BYTES) != hipSuccess || per_cu < 1) { fprintf(stderr, "kernel_launch: occupancy query says %d\n", per_cu); per_cu = 1; }
        (void)hipGetLastError();
        grid = cus;
    }
    if (grid < 0) return;
    Args a{};
    for (int i = 0; i < 13; ++i) a.in[i] = (const float*)d_in[i];
    a.out = (float*)d_out; a.ws = (unsigned char*)d_ws;
    if (hipMemsetAsync((char*)d_ws + OFF_BAR, 0, 32768, stream) != hipSuccess) { fprintf(stderr, "kernel_launch: memset failed\n"); return; }
#if N_LAUNCH_MODE == 1
    a.ph_lo = 0; a.ph_hi = 11 + (PROBE_REPEAT >= 0 ? 1 : 0);
    void* args[] = {&a};
    hipError_t e = hipLaunchCooperativeKernel((const void*)fwd_kernel, dim3(grid), dim3(512), args, LDS_BYTES, stream);
    if (e != hipSuccess) fprintf(stderr, "cooperative launch failed: %s (grid %d)\n", hipGetErrorString(e), grid);
#else
    for (int ph = 0; ph < 11; ++ph) { a.ph_lo = ph; a.ph_hi = ph + 1; hipLaunchKernelGGL(fwd_kernel, dim3(grid), dim3(512), LDS_BYTES, stream, a); }
#endif
}
```

```cpp
#include <hip/hip_runtime.h>
#include <hip/hip_cooperative_groups.h>
#include <cstdio>
#include <cstdint>
namespace cg = cooperative_groups;

#ifndef GEMM_ALIGN
#define GEMM_ALIGN true
#endif
#ifndef GEMM_SP2
#define GEMM_SP2 true
#endif
constexpr bool GA = GEMM_ALIGN, GS = GEMM_SP2;
#ifndef PROBE_REPEAT
#define PROBE_REPEAT -1
#endif
#ifndef N_LAUNCH_MODE
#define N_LAUNCH_MODE 1
#endif

#define LAS __attribute__((address_space(3)))
typedef unsigned short bf16_t;
typedef short bf16x8 __attribute__((ext_vector_type(8)));
typedef float f32x4 __attribute__((ext_vector_type(4)));
typedef float f32x2 __attribute__((ext_vector_type(2)));
typedef unsigned u32x4 __attribute__((ext_vector_type(4)));
typedef unsigned u32x2 __attribute__((ext_vector_type(2)));

constexpr int T_TOK = 49152, TP = 32768, DM = 1024, INW = 2432;
constexpr int LDP = 1792;
constexpr int N1PAD = 2816;
constexpr int C_U = 0, C_V = 384, C_BG = 768, C_CG = 1152, C_B = 1408, R_B = 1792, R_PC = 2304, R_PS = 2560;
constexpr float EPS = 1e-6f;
constexpr size_t OFF_W1T = 0;
constexpr size_t OFF_WOT = OFF_W1T + (size_t)2 * N1PAD * 1024 * 2;
constexpr size_t OFF_WSB = OFF_WOT + (size_t)2 * 1024 * 1024 * 2;
constexpr size_t OFF_DQ = OFF_WSB + (size_t)2 * 4 * 128 * 128 * 2;
constexpr size_t OFF_BAR = OFF_DQ + (size_t)256 * 512 * 2;
constexpr size_t OFF_RINV = OFF_BAR + 32768;
constexpr size_t OFF_XB = OFF_RINV + (size_t)T_TOK * 4;
constexpr size_t OFF_PROJ = OFF_XB + (size_t)T_TOK * 1024 * 2;
constexpr size_t OFF_PT = OFF_PROJ + (size_t)T_TOK * LDP * 2;
constexpr size_t OFF_YM = OFF_PT + (size_t)512 * T_TOK * 2;
constexpr size_t OFF_APT = OFF_YM + (size_t)T_TOK * 1024 * 2;
constexpr size_t WS_END = OFF_APT + (size_t)192 * 256 * 512 * 2;
constexpr int LDS_BYTES = 131072 + 64;

struct Args {
    const float* in[13];
    float* out;
    unsigned char* ws;
    int ph_lo, ph_hi;
};

__device__ __forceinline__ unsigned cvt_pk_bf16(float lo, float hi) { unsigned r; asm("v_cvt_pk_bf16_f32 %0, %1, %2" : "=v"(r) : "v"(lo), "v"(hi)); return r; }
__device__ __forceinline__ float bf_lo(unsigned w) { return __uint_as_float(w << 16); }
__device__ __forceinline__ float bf_hi(unsigned w) { return __uint_as_float(w & 0xffff0000u); }
__device__ __forceinline__ float wave_sum(float v) {
#pragma unroll
    for (int o = 1; o < 64; o <<= 1) v += __shfl_xor(v, o);
    return v;
}
__device__ __forceinline__ float sigmoid_fast(float z) { return __builtin_amdgcn_rcpf(1.0f + __builtin_amdgcn_exp2f(-1.4426950409f * z)); }
__device__ __forceinline__ float gelu_tanh(float x) { const float z = 1.5957691216f * (x + 0.044715f * x * x * x); return x * sigmoid_fast(z); }
__device__ __forceinline__ float silu_f(float x) { return x * sigmoid_fast(x); }

__device__ __forceinline__ int opaque_tid() { int t = threadIdx.x; asm volatile("" : "+v"(t)); return t; }
namespace pg8 {
constexpr int BM = 256, BK = 64, HALF = 128, HTB = HALF * BK * 2, STAGE_BYTES = 8 * HTB, NXCD = 8, WGM = 8;
__host__ __device__ __forceinline__ int lds_byte(int r, int c) { const int st = (r >> 4) * 2 + (c >> 5), rr = r & 15, cc = c & 31, ob = rr * 64 + cc * 2; return st * 1024 + (ob ^ (((ob >> 9) & 1) << 5)); }
__host__ __device__ __forceinline__ void stage_rc(int b, int& R, int& C) { const int st = b / 1024, sb = b % 1024, swz = sb ^ (((sb >> 9) & 1) << 5); R = (st >> 1) * 16 + swz / 64; C = (st & 1) * 32 + (swz % 64) / 2; }
__host__ __device__ __forceinline__ int perm32(int rho) { const int n = rho >> 4, i = rho & 15; return 8 * (i >> 2) + 4 * n + (i & 3); }
struct Unit { int pm, pn, kind, flag; const char* A; const char* B; };
struct Gemm { const bf16_t* A; const bf16_t* Bt; int M, N, K; };
struct StaticOrder {
    int nM, nN, nwg, G, c;
    __device__ void init(int M, int N, int G_, int c_) { nM = M / BM; nN = N / BM; nwg = nM * nN; G = G_; c = c_; }
    __device__ bool map(long L, int& pm, int& pn) const {
        if (L >= nwg) return false;
        int wgid = (int)L; { const int q = nwg / NXCD, r = nwg % NXCD, xcd = wgid % NXCD, off = wgid / NXCD; wgid = (xcd < r ? xcd * (q + 1) : r * (q + 1) + (xcd - r) * q) + off; }
        const int nig = WGM * nN, gid = wgid / nig, fm = gid * WGM, gsz = (nM - fm) < WGM ? (nM - fm) : WGM;
        pm = fm + ((wgid % nig) % gsz); pn = (wgid % nig) / gsz; return true;
    }
};
struct SchedPlain {
    StaticOrder o; const char* A; const char* Bt; size_t tstep;
    __device__ void init(const Gemm& g, int G, int c) { o.init(g.M, g.N, G, c); A = (const char*)g.A; Bt = (const char*)g.Bt; tstep = (size_t)256 * g.K * 2; }
    __device__ bool next(int i, Unit& u) const { if (!o.map((long)i * o.G + o.c, u.pm, u.pn)) return false; u.kind = 0; u.flag = 0; u.A = A + (size_t)u.pm * tstep; u.B = Bt + (size_t)u.pn * tstep; return true; }
    __device__ __forceinline__ void done(const Unit&, int) const {}
};
struct SchedG1 {
    StaticOrder o; const char* XB; const char* W; size_t tstep;
    __device__ void init(const bf16_t* xb, const bf16_t* w1t, int G, int c) { o.init(T_TOK, 2304, G, c); XB = (const char*)xb; W = (const char*)w1t; tstep = (size_t)256 * 1024 * 2; }
    unsigned* cnt;
    __device__ bool next(int i, Unit& u) const {
        const long L = (long)i * o.G + o.c;
        if (L < 1728) { o.map(L, u.pm, u.pn); u.kind = 0; u.flag = (L + o.G >= 1728) ? 1 : 0; u.A = XB + (size_t)u.pm * tstep; u.B = W + (size_t)u.pn * tstep; return true; }
        const int idx = (int)(L - 1728); if (idx >= 384) return false;
        u.pm = idx & 1; u.pn = idx >> 1; u.kind = 1; u.flag = 0; u.A = W + (size_t)(9 + u.pm) * tstep; u.B = XB + (size_t)u.pn * tstep; return true;
    }
    unsigned x, nwav, *xsub;
    __device__ __forceinline__ void done(const Unit& u, int lane) const {
        if (u.flag) {
            asm volatile("s_waitcnt vmcnt(0)" ::: "memory");
            if (lane == 0) {
                const unsigned old = __hip_atomic_fetch_add(xsub + 64 * x, 1u, __ATOMIC_RELAXED, __HIP_MEMORY_SCOPE_AGENT);
                if (old + 1u == nwav) {
                    __builtin_amdgcn_fence(__ATOMIC_RELEASE, "agent");
                    asm volatile("s_waitcnt vmcnt(0)" ::: "memory");
                    __hip_atomic_fetch_add(cnt, 1u, __ATOMIC_RELAXED, __HIP_MEMORY_SCOPE_AGENT);
                }
            }
        }
    }
};
template <bool ALIGN_EPI, bool SP2, class Epi, class Sched>
__device__ __forceinline__ void gemm_phase(LAS unsigned char* lds, const int K, const Sched& S, const Epi& E) {
    const int tid = opaque_tid(), wid = __builtin_amdgcn_readfirstlane(tid >> 6), lane = tid & 63, wr = wid >> 2, wc = wid & 3, fr = lane & 15, fq = lane >> 4;
    const int nt = K / BK;
    unsigned voffA[2], voffB[2];
#pragma unroll
    for (int i = 0; i < 2; ++i) { int R, C; stage_rc(tid * 16 + i * 8192, R, C); const int Rb = (R & ~31) + perm32(R & 31);
        voffA[i] = (unsigned)(R * K + C) * 2u; voffB[i] = (unsigned)(Rb * K + C) * 2u; }
    const size_t kstep = (size_t)(BK * 2);
    const size_t hstep = (size_t)HALF * K * 2;
    const unsigned ldsw = (unsigned)wid * 1024u;
    const int aoff = lds_byte(wr * 64 + fr, fq * 8), boff = lds_byte(wc * 32 + fr, fq * 8);
#define PG8_SA(b, h) (((b) * 2 + (h)) * HTB)
#define PG8_SB(b, h) ((4 + (b) * 2 + (h)) * HTB)
#define PG8_STAGE(bufoff, gbase, voff) do { _Pragma("unroll") for (int _i = 0; _i < 2; ++_i) \
        __builtin_amdgcn_global_load_lds((const unsigned*)((const char*)(gbase) + (voff)[_i]), (LAS unsigned*)(lds + (bufoff) + ldsw + _i * 8192), 16, 0, 0); } while (0)
#define PG8_LDA(dst, b, h) do { _Pragma("unroll") for (int m = 0; m < 4; ++m) _Pragma("unroll") for (int k = 0; k < 2; ++k) dst[m][k] = *(const LAS bf16x8*)(lds + PG8_SA(b, h) + aoff + m * 2048 + k * 1024); } while (0)
#define PG8_LDB(dst, b, h) do { _Pragma("unroll") for (int n = 0; n < 2; ++n) _Pragma("unroll") for (int k = 0; k < 2; ++k) dst[n][k] = *(const LAS bf16x8*)(lds + PG8_SB(b, h) + boff + n * 2048 + k * 1024); } while (0)
#define PG8_MMA(ai, bj, At, Bt) do { __builtin_amdgcn_s_setprio(1); _Pragma("unroll") for (int m = 0; m < 4; ++m) _Pragma("unroll") for (int n = 0; n < 2; ++n) _Pragma("unroll") for (int k = 0; k < 2; ++k) \
        acc[ai][bj][m][n] = __builtin_amdgcn_mfma_f32_16x16x32_bf16(Bt[n][k], At[m][k], acc[ai][bj][m][n], 0, 0, 0); __builtin_amdgcn_s_setprio(0); } while (0)
#define PG8_WAIT_V(n) asm volatile("s_waitcnt vmcnt(" #n ")" ::: "memory")
#define PG8_WAIT_L(n) asm volatile("s_waitcnt lgkmcnt(" #n ")" ::: "memory")
#define PG8_BAR __builtin_amdgcn_s_barrier()
#define PG8_SCHED __builtin_amdgcn_sched_barrier(0)
    Unit cur, nxt; int ui = 0;
    if (!S.next(0, cur)) return;
    f32x4 acc[2][2][4][2];
#pragma unroll
    for (int a = 0; a < 2; ++a)
#pragma unroll
        for (int b = 0; b < 2; ++b)
#pragma unroll
            for (int m = 0; m < 4; ++m)
#pragma unroll
                for (int n = 0; n < 2; ++n) acc[a][b][m][n] = (f32x4){0.f, 0.f, 0.f, 0.f};
    bf16x8 At[4][2], B0[2][2], B1[2][2];
    const char* cA = cur.A; const char* cB = cur.B;
    if constexpr (SP2) {
        PG8_STAGE(PG8_SB(0, 0), cB, voffB); PG8_STAGE(PG8_SB(0, 1), cB + hstep, voffB); PG8_STAGE(PG8_SA(0, 0), cA, voffA); PG8_STAGE(PG8_SA(0, 1), cA + hstep, voffA);
        if (wr == 1) PG8_BAR;
        PG8_WAIT_V(2); PG8_BAR;
        PG8_STAGE(PG8_SB(1, 0), cB + kstep, voffB); PG8_STAGE(PG8_SA(1, 0), cA + kstep, voffA); PG8_STAGE(PG8_SB(1, 1), cB + hstep + kstep, voffB);
        PG8_WAIT_V(6); PG8_BAR;
    } else {
    PG8_STAGE(PG8_SB(0, 0), cB, voffB); PG8_STAGE(PG8_SA(0, 0), cA, voffA); PG8_STAGE(PG8_SB(0, 1), cB + hstep, voffB); PG8_STAGE(PG8_SA(0, 1), cA + hstep, voffA);
    if (wr == 1) PG8_BAR;
    PG8_WAIT_V(4); PG8_BAR;
    PG8_STAGE(PG8_SB(1, 0), cB + kstep, voffB); PG8_STAGE(PG8_SA(1, 0), cA + kstep, voffA); PG8_STAGE(PG8_SB(1, 1), cB + hstep + kstep, voffB);
    PG8_WAIT_V(6); PG8_BAR;
    }
    for (;;) {
        const bool has_next = S.next(ui + 1, nxt);
        const char* nA = has_next ? nxt.A : cA; const char* nB = has_next ? nxt.B : cB;
        for (int t = 0; t < nt; t += 2) {
            const bool last = (t == nt - 2);
            const char* a1 = cA + (size_t)(t + 1) * kstep;
            const char* a2 = last ? nA : cA + (size_t)(t + 2) * kstep; const char* b2 = last ? nB : cB + (size_t)(t + 2) * kstep;
            const char* a3 = a2 + kstep; const char* b3 = b2 + kstep;
            if constexpr (SP2) {
            PG8_LDB(B0, 0, 0); PG8_LDB(B1, 0, 1); PG8_SCHED; PG8_LDA(At, 0, 0); PG8_STAGE(PG8_SA(1, 1), a1 + hstep, voffA);
            PG8_WAIT_V(8); PG8_WAIT_L(0); PG8_BAR; PG8_MMA(0, 0, At, B0); PG8_MMA(0, 1, At, B1); PG8_BAR; PG8_SCHED;
            PG8_LDA(At, 0, 1); PG8_STAGE(PG8_SB(0, 0), b2, voffB); PG8_STAGE(PG8_SB(0, 1), b2 + hstep, voffB); PG8_STAGE(PG8_SA(0, 0), a2, voffA);
            PG8_WAIT_V(8); PG8_WAIT_L(0); PG8_BAR; PG8_MMA(1, 0, At, B0); PG8_MMA(1, 1, At, B1); PG8_BAR; PG8_SCHED;
            PG8_LDB(B0, 1, 0); PG8_LDB(B1, 1, 1); PG8_SCHED; PG8_LDA(At, 1, 0); PG8_STAGE(PG8_SA(0, 1), a2 + hstep, voffA);
            PG8_WAIT_V(8); PG8_WAIT_L(0); PG8_BAR; PG8_MMA(0, 0, At, B0); PG8_MMA(0, 1, At, B1); PG8_BAR; PG8_SCHED;
            PG8_LDA(At, 1, 1); PG8_STAGE(PG8_SB(1, 0), b3, voffB); PG8_STAGE(PG8_SB(1, 1), b3 + hstep, voffB); PG8_STAGE(PG8_SA(1, 0), a3, voffA);
            PG8_WAIT_V(8); PG8_WAIT_L(0); PG8_BAR; PG8_MMA(1, 0, At, B0); PG8_MMA(1, 1, At, B1); PG8_BAR; PG8_SCHED;
            } else {
            PG8_LDB(B0, 0, 0); PG8_SCHED; PG8_LDA(At, 0, 0); PG8_STAGE(PG8_SA(1, 1), a1 + hstep, voffA);
            PG8_WAIT_L(8); PG8_BAR; PG8_WAIT_L(0); PG8_MMA(0, 0, At, B0); PG8_BAR; PG8_SCHED;
            PG8_LDB(B1, 0, 1); PG8_STAGE(PG8_SB(0, 0), b2, voffB);
            PG8_BAR; PG8_WAIT_L(0); PG8_MMA(0, 1, At, B1); PG8_BAR;
            PG8_LDA(At, 0, 1); PG8_STAGE(PG8_SA(0, 0), a2, voffA);
            PG8_BAR; PG8_WAIT_L(0); PG8_MMA(1, 0, At, B0); PG8_BAR; PG8_SCHED;
            PG8_STAGE(PG8_SB(0, 1), b2 + hstep, voffB);
            PG8_WAIT_V(6); PG8_BAR; PG8_MMA(1, 1, At, B1); PG8_BAR;
            PG8_LDB(B0, 1, 0); PG8_SCHED; PG8_LDA(At, 1, 0); PG8_STAGE(PG8_SA(0, 1), a2 + hstep, voffA);
            PG8_WAIT_L(8); PG8_BAR; PG8_WAIT_L(0); PG8_MMA(0, 0, At, B0); PG8_BAR; PG8_SCHED;
            PG8_LDB(B1, 1, 1); PG8_STAGE(PG8_SB(1, 0), b3, voffB);
            PG8_BAR; PG8_WAIT_L(0); PG8_MMA(0, 1, At, B1); PG8_BAR;
            PG8_LDA(At, 1, 1); PG8_STAGE(PG8_SA(1, 0), a3, voffA);
            PG8_BAR; PG8_WAIT_L(0); PG8_MMA(1, 0, At, B0); PG8_BAR; PG8_SCHED;
            PG8_STAGE(PG8_SB(1, 1), b3 + hstep, voffB);
            PG8_WAIT_V(6); PG8_BAR; PG8_MMA(1, 1, At, B1); PG8_BAR;
                    }
        }
        if constexpr (ALIGN_EPI) { if (wr == 0) PG8_BAR; }
        E(acc, cur, wr, wc, fr, fq);
        S.done(cur, lane);
        if (!has_next) break;
#pragma unroll
        for (int a = 0; a < 2; ++a)
#pragma unroll
            for (int b = 0; b < 2; ++b)
#pragma unroll
                for (int m = 0; m < 4; ++m)
#pragma unroll
                    for (int n = 0; n < 2; ++n) acc[a][b][m][n] = (f32x4){0.f, 0.f, 0.f, 0.f};
        cur = nxt; cA = nA; cB = nB; ++ui;
        if constexpr (ALIGN_EPI) { if (wr == 1) PG8_BAR; }
    }
    PG8_WAIT_V(0);
    if constexpr (!ALIGN_EPI) { if (wr == 0) PG8_BAR; }
    PG8_BAR;
#undef PG8_SA
#undef PG8_SB
#undef PG8_STAGE
#undef PG8_LDA
#undef PG8_LDB
#undef PG8_MMA
#undef PG8_WAIT_V
#undef PG8_WAIT_L
#undef PG8_BAR
#undef PG8_SCHED
}
}
using pg8::Unit;

template <int ACT> __device__ __forceinline__ float act_f(float x) { if (ACT == 0) return gelu_tanh(x); if (ACT == 1) return silu_f(x); return x; }

struct EpiProj {
    bf16_t* O; bf16_t* PT;
    template <int ACT0, int ACT1> __device__ __forceinline__ void body(const f32x4 (&acc)[2][2][4][2], bf16_t* base, size_t ld, int nbj) const {
#pragma unroll
        for (int ai = 0; ai < 2; ++ai)
#pragma unroll
            for (int m = 0; m < 4; ++m) { bf16_t* rowp = base + (size_t)(ai * 128 + m * 16) * ld;
#pragma unroll
                for (int bj = 0; bj < 2; ++bj) { if (bj < nbj) { const f32x4 v0 = acc[ai][bj][m][0], v1 = acc[ai][bj][m][1]; u32x4 w;
                    if (bj == 0) { w.x = cvt_pk_bf16(act_f<ACT0>(v0[0]), act_f<ACT0>(v0[1])); w.y = cvt_pk_bf16(act_f<ACT0>(v0[2]), act_f<ACT0>(v0[3]));
                        w.z = cvt_pk_bf16(act_f<ACT0>(v1[0]), act_f<ACT0>(v1[1])); w.w = cvt_pk_bf16(act_f<ACT0>(v1[2]), act_f<ACT0>(v1[3])); }
                    else { w.x = cvt_pk_bf16(act_f<ACT1>(v0[0]), act_f<ACT1>(v0[1])); w.y = cvt_pk_bf16(act_f<ACT1>(v0[2]), act_f<ACT1>(v0[3]));
                        w.z = cvt_pk_bf16(act_f<ACT1>(v1[0]), act_f<ACT1>(v1[1])); w.w = cvt_pk_bf16(act_f<ACT1>(v1[2]), act_f<ACT1>(v1[3])); }
                    *(u32x4*)(rowp + bj * 128) = w; } } }
    }
    __device__ __forceinline__ void body_ug(const f32x4 (&acc)[2][2][4][2], bf16_t* base) const {
#pragma unroll
        for (int ai = 0; ai < 2; ++ai)
#pragma unroll
            for (int m = 0; m < 4; ++m) { const f32x4 u0 = acc[ai][0][m][0], u1 = acc[ai][0][m][1], g0 = acc[ai][1][m][0], g1 = acc[ai][1][m][1]; u32x4 w;
                w.x = cvt_pk_bf16(gelu_tanh(u0[0]) * silu_f(g0[0]), gelu_tanh(u0[1]) * silu_f(g0[1])); w.y = cvt_pk_bf16(gelu_tanh(u0[2]) * silu_f(g0[2]), gelu_tanh(u0[3]) * silu_f(g0[3]));
                w.z = cvt_pk_bf16(gelu_tanh(u1[0]) * silu_f(g1[0]), gelu_tanh(u1[1]) * silu_f(g1[1])); w.w = cvt_pk_bf16(gelu_tanh(u1[2]) * silu_f(g1[2]), gelu_tanh(u1[3]) * silu_f(g1[3]));
                *(u32x4*)(base + (size_t)(ai * 128 + m * 16) * LDP) = w; }
    }
    __device__ __forceinline__ void operator()(const f32x4 (&acc)[2][2][4][2], const Unit& u, int wr, int wc, int fr, int fq) const {
        const int row0 = u.pm * 256 + wr * 64 + fr, cw = wc * 32 + 8 * fq;
        if (u.kind == 1) { body<2, 2>(acc, PT + (size_t)row0 * T_TOK + u.pn * 256 + cw, (size_t)T_TOK, 2); return; }
        if (u.pn < 3) { body_ug(acc, O + (size_t)row0 * LDP + u.pn * 128 + cw); return; }
        bf16_t* base = O + (size_t)row0 * LDP + (u.pn * 256 - 384) + cw; const int nbj = (u.pn == 8) ? 1 : 2;
        if (u.pn == 3) body<0, 0>(acc, base, (size_t)LDP, nbj); else if (u.pn == 4) body<0, 1>(acc, base, (size_t)LDP, nbj);
        else if (u.pn < 7) body<1, 1>(acc, base, (size_t)LDP, nbj); else body<2, 2>(acc, base, (size_t)LDP, nbj);
    }
};
struct EpiY {
    bf16_t* O;
    __device__ __forceinline__ void operator()(const f32x4 (&acc)[2][2][4][2], const Unit& u, int wr, int wc, int fr, int fq) const {
        const int row0 = u.pm * 256 + wr * 64 + fr, col0 = u.pn * 256 + wc * 32 + 8 * fq;
#pragma unroll
        for (int ai = 0; ai < 2; ++ai)
#pragma unroll
            for (int m = 0; m < 4; ++m) { bf16_t* rowp = O + (size_t)(row0 + ai * 128 + m * 16) * 1024 + col0;
#pragma unroll
                for (int bj = 0; bj < 2; ++bj) { const f32x4 v0 = acc[ai][bj][m][0], v1 = acc[ai][bj][m][1];
                    u32x4 w; w.x = cvt_pk_bf16(v0[0], v0[1]); w.y = cvt_pk_bf16(v0[2], v0[3]); w.z = cvt_pk_bf16(v1[0], v1[1]); w.w = cvt_pk_bf16(v1[2], v1[3]);
                    *(u32x4*)(rowp + bj * 128) = w; } }
    }
};
struct EpiDft {
    const bf16_t* P; bf16_t* Y;
    __device__ __forceinline__ void operator()(const f32x4 (&acc)[2][2][4][2], const Unit& u, int wr, int wc, int fr, int fq) const {
        const int j = u.pn; int tokbase, k1, R;
        if (j < 128) { tokbase = (j >> 3) * 2048; k1 = j & 7; R = 8; } else { const int jj = j - 128; tokbase = TP + (jj >> 4) * 4096; k1 = jj & 15; R = 16; }
        const int ch0 = wc * 32 + 8 * fq;
#pragma unroll
        for (int ai = 0; ai < 2; ++ai) {
            u32x4 gt[4][2];
#pragma unroll
            for (int m = 0; m < 4; ++m) { const int k2 = ai * 128 + wr * 64 + m * 16 + fr; const size_t tok = (size_t)(tokbase + k1 + R * k2);
#pragma unroll
                for (int bj = 0; bj < 2; ++bj) gt[m][bj] = *(const u32x4*)(P + tok * LDP + C_CG + ch0 + bj * 128); }
#pragma unroll
            for (int m = 0; m < 4; ++m) { const int k2 = ai * 128 + wr * 64 + m * 16 + fr; const size_t tok = (size_t)(tokbase + k1 + R * k2);
#pragma unroll
                for (int bj = 0; bj < 2; ++bj) { const u32x4 g = gt[m][bj];
                    const f32x4 v0 = acc[ai][bj][m][0], v1 = acc[ai][bj][m][1];
                    u32x4 w; w.x = cvt_pk_bf16(v0[0] * bf_lo(g.x), v0[1] * bf_hi(g.x)); w.y = cvt_pk_bf16(v0[2] * bf_lo(g.y), v0[3] * bf_hi(g.y));
                    w.z = cvt_pk_bf16(v1[0] * bf_lo(g.z), v1[1] * bf_hi(g.z)); w.w = cvt_pk_bf16(v1[2] * bf_lo(g.w), v1[3] * bf_hi(g.w));
                    *(u32x4*)(Y + tok * 1024 + 768 + ch0 + bj * 128) = w; } }
        }
    }
};

struct Ctx {
    const float *xp, *xs, *pre_g, *w_in, *a_ln_g, *a_ln_b, *a_w_s, *a_b_s, *b_w, *b_scale, *c_w, *w_out, *post_g;
    float* out;
    bf16_t *W1T, *WOT, *WSB, *DQ, *XB, *APT, *PROJ, *PT, *YO, *YM; float* RINV;
};

__device__ __forceinline__ void transpose_item(const float* W, int ldn, int col0, const float* ks, bf16_t* WT, int row0, int k0, LAS float* scr, int lane) {
    float tv[32];
#pragma unroll
    for (int i = 0; i < 32; ++i) { const int kk = 2 * i + (lane >> 5); tv[i] = W[(size_t)(k0 + kk) * ldn + col0 + (lane & 31)]; }
    if (ks) {
#pragma unroll
        for (int i = 0; i < 32; ++i) tv[i] *= ks[k0 + 2 * i + (lane >> 5)]; }
#pragma unroll
    for (int i = 0; i < 32; ++i) scr[(2 * i + (lane >> 5)) * 33 + (lane & 31)] = tv[i];
    asm volatile("s_waitcnt lgkmcnt(0)" ::: "memory");
    const int c = lane & 7;
#pragma unroll
    for (int j = 0; j < 4; ++j) { const int n = (lane >> 3) + 8 * j; const LAS float* s = scr + (8 * c) * 33 + n;
        u32x4 o; o.x = cvt_pk_bf16(s[0 * 33], s[1 * 33]); o.y = cvt_pk_bf16(s[2 * 33], s[3 * 33]); o.z = cvt_pk_bf16(s[4 * 33], s[5 * 33]); o.w = cvt_pk_bf16(s[6 * 33], s[7 * 33]);
        *(u32x4*)(WT + (size_t)(row0 + n) * 1024 + k0 + 8 * c) = o; }
    asm volatile("s_waitcnt lgkmcnt(0)" ::: "memory");
}

template <int GD, int NP>
__device__ __forceinline__ void fold_compute(const Ctx& C, int l, int k0, int srccol, LAS float* Gm  , LAS float* Ws  , int dst0, int dst1) {
    constexpr int GS = NP + 4, J = NP / 8;
    const int tid = opaque_tid();
    { float wv[64 * GD / 512], pgv[64 * GD / 512];
#pragma unroll
      for (int j = 0; j < 64 * GD / 512; ++j) { const int idx = tid + 512 * j; const int kk = idx / GD, c = idx - kk * GD;
          wv[j] = C.w_in[(size_t)l * 1024 * INW + (size_t)(k0 + kk) * INW + srccol + c]; pgv[j] = C.pre_g[l * 1024 + k0 + kk]; }
#pragma unroll
      for (int j = 0; j < 64 * GD / 512; ++j) { const int idx = tid + 512 * j; const int kk = idx / GD, c = idx - kk * GD; Ws[kk * (GD + 1) + c] = wv[j] * pgv[j]; } }
    __syncthreads();
    const int kk = tid & 63, wv = tid >> 6, n0 = wv * J;
    float acc[J];
#pragma unroll
    for (int j = 0; j < J; ++j) acc[j] = 0.f;
#pragma unroll 4
    for (int c = 0; c < GD; ++c) { const float w = Ws[kk * (GD + 1) + c];
#pragma unroll
        for (int jj = 0; jj < J / 4; ++jj) { const f32x4 g4 = *(const LAS f32x4*)(Gm + c * GS + n0 + 4 * jj);
            acc[4 * jj + 0] += w * g4[0]; acc[4 * jj + 1] += w * g4[1]; acc[4 * jj + 2] += w * g4[2]; acc[4 * jj + 3] += w * g4[3]; } }
    bf16_t* WT = C.W1T + (size_t)l * N1PAD * 1024;
#pragma unroll
    for (int j = 0; j < J; ++j) { const int n = n0 + j; const int row = (NP == 128 && n >= 64) ? (dst1 + n - 64) : (dst0 + n);
        WT[(size_t)row * 1024 + k0 + kk] = (bf16_t)(cvt_pk_bf16(acc[j], 0.f) & 0xffffu); }
    __syncthreads();
}
__device__ __forceinline__ void fold_item(const Ctx& C, int it, LAS unsigned char* lds) {
    const int l = it >> 7, r = it & 127, grp = r >> 4, kb = r & 15, k0 = kb * 64, tid = opaque_tid();
    LAS float* Gm = (LAS float*)lds;
    LAS float* Ws = (LAS float*)(lds + 40960);
    LAS float* Wc = (LAS float*)(lds + 69632);
    LAS float* tb = (LAS float*)(lds + 90112);
    if (grp < 4) {
        const int g = grp;
        { float bw[18], bs[18];
#pragma unroll
          for (int j = 0; j < 18; ++j) { const int idx = tid + 512 * j; const int c = idx / 96, n = idx - c * 96; bw[j] = C.b_w[((size_t)(l * 4 + g) * 96 + c) * 96 + n]; bs[j] = C.b_scale[l * 384 + g * 96 + n]; }
#pragma unroll
          for (int j = 0; j < 18; ++j) { const int idx = tid + 512 * j; const int c = idx / 96, n = idx - c * 96; Gm[c * 100 + n] = bw[j] * bs[j]; } }
        fold_compute<96, 96>(C, l, k0, 1152 + g * 96, Gm, Ws, R_B + g * 96, 0);
    } else {
        const int g = grp - 4;
        if (tid < 64) { float s, c; sincospif((float)tid * (1.0f / 32.0f), &s, &c); tb[tid] = c; tb[64 + tid] = s; }
        { float cw[8];
#pragma unroll
          for (int j = 0; j < 8; ++j) cw[j] = C.c_w[(size_t)(l * 4 + g) * 4096 + tid + 512 * j];
#pragma unroll
          for (int j = 0; j < 8; ++j) { const int idx = tid + 512 * j; Wc[(idx >> 6) * 65 + (idx & 63)] = cw[j]; } }
        __syncthreads();
        for (int idx = tid; idx < 4096; idx += 512) { const int c = idx >> 6, d = idx & 63; float gc = 0.f, gs = 0.f;
#pragma unroll 16
            for (int m = 0; m < 64; ++m) { const float w = Wc[m * 65 + d]; const int ph = (m * c) & 63; gc += tb[ph] * w; gs += tb[64 + ph] * w; }
            Gm[c * 132 + d] = gc; Gm[c * 132 + 64 + d] = gs; }
        fold_compute<64, 128>(C, l, k0, 1920 + g * 64, Gm, Ws, R_PC + g * 64, R_PS + g * 64);
    }
}
__device__ __forceinline__ const float* xrow_ptr(const Ctx& C, int t) { return t < TP ? C.xp + (size_t)t * 1024 : C.xs + (size_t)(t - TP) * 1024; }

__device__ __forceinline__ void weight_prep(const Ctx& C, LAS unsigned char* lds, int l, int vb, int NB) {
    const int tid = opaque_tid(), lane = tid & 63, wave = tid >> 6;
    for (int it = vb; it < 128; it += NB) fold_item(C, l * 128 + it, lds);
    const int gw = vb * 8 + wave, NGW = NB * 8;
    LAS float* scr = (LAS float*)(lds + wave * 8704);
    for (int r = gw; r < 1408; r += NGW) {
        if (r < 896) { const int nb = r >> 4, kb = r & 15, dst = nb * 32;
            int src;
            if (dst < 768) { const int t = dst >> 8, r = dst & 255; src = (r < 128) ? 128 * t + r : 768 + 128 * t + (r - 128); }
            else if (dst < 1152) src = dst - 768 + 384; else if (dst < 1536) src = dst - 1152 + 1536; else src = dst - 1536 + 2176;
            transpose_item(C.w_in + (size_t)l * 1024 * INW, INW, src, C.pre_g + l * 1024, C.W1T + (size_t)l * N1PAD * 1024, dst, kb * 64, scr, lane);
        } else { const int r2 = r - 896; const int nb = r2 >> 4, kb = r2 & 15;
            transpose_item(C.w_out + (size_t)l * 1024 * 1024, 1024, nb * 32, nullptr, C.WOT + (size_t)l * 1024 * 1024, nb * 32, kb * 64, scr, lane); }
    }
    const int gt = vb * 512 + tid, NGT = NB * 512;
    for (int r = gt; r < 128 * 128; r += NGT) *(u32x4*)(C.W1T + (size_t)l * N1PAD * 1024 + (size_t)2176 * 1024 + (size_t)r * 8) = (u32x4){0u, 0u, 0u, 0u};
    for (int i = gt; i < 4 * 128 * 128 / 2; i += NGT) { const size_t e = (size_t)l * 4 * 128 * 128 + 2 * (size_t)i; const f32x2 v = *(const f32x2*)(C.a_w_s + e); *(unsigned*)(C.WSB + e) = cvt_pk_bf16(v.x, v.y); }
}
__device__ __forceinline__ void p0_prologue(const Ctx& C, LAS unsigned char* lds) {
#pragma unroll 1
    for (int l = 0; l < 2; ++l) weight_prep(C, lds, l, (blockIdx.x + 128 * l) % gridDim.x, gridDim.x);
    const int tid = opaque_tid(), lane = tid & 63, wave = tid >> 6, G = gridDim.x, bid = blockIdx.x;
    const int gw = bid * 8 + wave, NGW = G * 8;
    const int gt = bid * 512 + tid, NGT = G * 512;
    for (int i = gt; i < 256 * 512; i += NGT) { const int k2 = i >> 9, jj = i & 511, s2 = jj & 255; const int ph = (k2 * s2) & 255; float s, c; sincospif((float)ph * (1.0f / 128.0f), &s, &c);
        C.DQ[i] = (bf16_t)(cvt_pk_bf16(jj < 256 ? c : -s, 0.f) & 0xffffu); }
    for (int t4 = gw; t4 < T_TOK / 4; t4 += NGW) {
        const f32x4* xr = (const f32x4*)xrow_ptr(C, 4 * t4) + lane; f32x4 v[4][4]; float s[4];
#pragma unroll
        for (int r = 0; r < 4; ++r)
#pragma unroll
            for (int j = 0; j < 4; ++j) v[r][j] = xr[256 * r + 64 * j];
#pragma unroll
        for (int r = 0; r < 4; ++r) { s[r] = 0.f;
#pragma unroll
            for (int j = 0; j < 4; ++j) s[r] += (v[r][j].x * v[r][j].x + v[r][j].y * v[r][j].y) + (v[r][j].z * v[r][j].z + v[r][j].w * v[r][j].w); }
#pragma unroll
        for (int o = 1; o < 64; o <<= 1) {
#pragma unroll
            for (int r = 0; r < 4; ++r) s[r] += __shfl_xor(s[r], o); }
        u32x2* op = (u32x2*)(C.XB + (size_t)(4 * t4) * 1024) + lane;
#pragma unroll
        for (int r = 0; r < 4; ++r) { const float ms = s[r] * (1.0f / 1024.0f) + EPS; const float rs = rsqrtf(ms); if (lane == 0) C.RINV[4 * t4 + r] = ms * rs;
#pragma unroll
            for (int j = 0; j < 4; ++j) { u32x2 w; w.x = cvt_pk_bf16(v[r][j].x * rs, v[r][j].y * rs); w.y = cvt_pk_bf16(v[r][j].z * rs, v[r][j].w * rs); op[256 * r + 64 * j] = w; } }
    }
}

constexpr int VSTR = 136;
struct VPre { u32x4 p[3]; };
struct UGPre { u32x2 u[6]; };
__device__ __forceinline__ VPre mixer_a_load_v(const Ctx& C, int unit, int tid) {
    const int c = unit >> 2, h = unit & 3, q = tid >> 2, part = tid & 3;
    const bf16_t* src = C.PROJ + (size_t)(c * 128 + q) * LDP + C_V + h * 96 + part * 24;
    VPre r;
#pragma unroll
    for (int i = 0; i < 3; ++i) r.p[i] = *(const u32x4*)(src + 8 * i);
    return r;
}
__device__ __forceinline__ UGPre mixer_a_load_ug(const Ctx& C, int unit, int w, int fr, int fq) {
    const int c = unit >> 2, h = unit & 3; const size_t tok = (size_t)(c * 128 + 16 * w + fr);
    UGPre r;
#pragma unroll
    for (int nb = 0; nb < 6; ++nb) { const int dc = h * 96 + nb * 16 + 4 * fq; r.u[nb] = *(const u32x2*)(C.PROJ + tok * LDP + C_U + dc); }
    return r;
}
__device__ __forceinline__ void mixer_a_units(const Ctx& C, int l, LAS unsigned char* lds) {
    const int tid = opaque_tid(), lane = tid & 63, w = tid >> 6, fr = lane & 15, fq = lane >> 4, G = gridDim.x;
    LAS bf16_t* vt = (LAS bf16_t*)lds;
    int unit = blockIdx.x;
    if (unit >= 1536) return;
    const int q = tid >> 2, part = tid & 3, d0 = part * 24, p = 16 * w + fr;
    VPre vp = mixer_a_load_v(C, unit, tid);
    UGPre ugn = mixer_a_load_ug(C, unit, w, fr, fq);
    int hcur = -1; float lg[24], lb[24], bias = 0.f; bf16x8 af[4];
    for (; unit < 1536; unit += G) {
        const int c = unit >> 2, h = unit & 3, t0 = c * 128;
        if (h != hcur) {
            hcur = h;
#pragma unroll
            for (int i = 0; i < 24; i += 4) { const f32x4 g4 = *(const f32x4*)(C.a_ln_g + l * 384 + h * 96 + d0 + i), b4 = *(const f32x4*)(C.a_ln_b + l * 384 + h * 96 + d0 + i);
                lg[i] = g4[0]; lg[i + 1] = g4[1]; lg[i + 2] = g4[2]; lg[i + 3] = g4[3]; lb[i] = b4[0]; lb[i + 1] = b4[1]; lb[i + 2] = b4[2]; lb[i + 3] = b4[3]; }
            const bf16_t* wsrow = C.WSB + ((size_t)(l * 4 + h) * 128 + p) * 128 + 8 * fq;
#pragma unroll
            for (int ks = 0; ks < 4; ++ks) af[ks] = *(const bf16x8*)(wsrow + ks * 32);
            bias = C.a_b_s[(l * 4 + h) * 128 + p];
        }
        {
            float v[24];
#pragma unroll
            for (int i = 0; i < 3; ++i) { const u32x4 pk = vp.p[i];
                v[8 * i + 0] = bf_lo(pk.x); v[8 * i + 1] = bf_hi(pk.x); v[8 * i + 2] = bf_lo(pk.y); v[8 * i + 3] = bf_hi(pk.y);
                v[8 * i + 4] = bf_lo(pk.z); v[8 * i + 5] = bf_hi(pk.z); v[8 * i + 6] = bf_lo(pk.w); v[8 * i + 7] = bf_hi(pk.w); }
            float s = 0.f;
#pragma unroll
            for (int i = 0; i < 24; ++i) s += v[i];
            s += __shfl_xor(s, 1); s += __shfl_xor(s, 2);
            const float mean = s * (1.0f / 96.0f); float q2 = 0.f;
#pragma unroll
            for (int i = 0; i < 24; ++i) { v[i] -= mean; q2 += v[i] * v[i]; }
            q2 += __shfl_xor(q2, 1); q2 += __shfl_xor(q2, 2);
            const float rstd = rsqrtf(q2 * (1.0f / 96.0f) + EPS);
            const int qs = q ^ (part << 4);
#pragma unroll
            for (int i = 0; i < 24; ++i) { const float o = v[i] * rstd * lg[i] + lb[i]; vt[(d0 + i) * VSTR + qs] = (bf16_t)(cvt_pk_bf16(o, 0.f) & 0xffffu); }
        }
        const UGPre ug = ugn;
        __syncthreads();
        if (unit + G < 1536) { vp = mixer_a_load_v(C, unit + G, tid); ugn = mixer_a_load_ug(C, unit + G, w, fr, fq); }
        f32x4 acc[6];
#pragma unroll
        for (int nb = 0; nb < 6; ++nb) { acc[nb] = (f32x4){0.f, 0.f, 0.f, 0.f}; const int d = nb * 16 + fr, pr2 = 2 * (d / 24);
#pragma unroll
            for (int ks = 0; ks < 4; ++ks) { const bf16x8 bfr = *(const LAS bf16x8*)(vt + d * VSTR + (((ks * 4 + fq) ^ pr2) << 3));
                acc[nb] = __builtin_amdgcn_mfma_f32_16x16x32_bf16(bfr, af[ks], acc[nb], 0, 0, 0); } }
        const size_t tok = (size_t)(t0 + p);
#pragma unroll
        for (int nb = 0; nb < 6; ++nb) { const int dc = h * 96 + nb * 16 + 4 * fq;
            u32x2 o; o.x = cvt_pk_bf16((acc[nb][0] + bias) * bf_lo(ug.u[nb].x), (acc[nb][1] + bias) * bf_hi(ug.u[nb].x));
            o.y = cvt_pk_bf16((acc[nb][2] + bias) * bf_lo(ug.u[nb].y), (acc[nb][3] + bias) * bf_hi(ug.u[nb].y));
            *(u32x2*)(C.YM + tok * 1024 + dc) = o; }
        __syncthreads();
    }
}

__device__ __forceinline__ void acc8(float (&s)[8], const u32x4 p, float m) {
    s[0] += m * bf_lo(p.x); s[1] += m * bf_hi(p.x); s[2] += m * bf_lo(p.y); s[3] += m * bf_hi(p.y); s[4] += m * bf_lo(p.z); s[5] += m * bf_hi(p.z); s[6] += m * bf_lo(p.w); s[7] += m * bf_hi(p.w);
}
__device__ __forceinline__ void mixer_b_run(const Ctx& C, int item) {
    const int run = item / 48, cb = item - run * 48, g = cb / 12, half = 1 << g, t0 = run * 32;
    int S, pos0;
    if (t0 < TP) { S = 2048; pos0 = t0 & 2047; } else { S = 4096; pos0 = (t0 - TP) & 4095; }
    const bf16_t* zb = C.PROJ + (size_t)(t0 - pos0) * LDP + C_B + cb * 8;
    const bf16_t* gb = C.PROJ + (size_t)(t0 - pos0) * LDP + C_BG + cb * 8;
    bf16_t* yb = C.YM + (size_t)(t0 - pos0) * 1024 + 384 + cb * 8;
    float s[8];
#pragma unroll
    for (int i = 0; i < 8; ++i) s[i] = 0.f;
    int cnt = 0;
#pragma unroll
    for (int d = -8; d < 8; ++d) { const int tau = pos0 + d; const bool ok = (d >= -half) && (d < half) && (tau >= 0) && (tau < S);
        const int tc = min(max(tau, 0), S - 1); const u32x4 p = *(const u32x4*)(zb + (size_t)tc * LDP); acc8(s, p, ok ? 1.f : 0.f); cnt += ok ? 1 : 0; }
#pragma unroll 4
    for (int i = 0; i < 32; ++i) {
        const int pos = pos0 + i, lead = pos + half, trail = pos - half;
        const u32x4 zc = *(const u32x4*)(zb + (size_t)pos * LDP), gt = *(const u32x4*)(gb + (size_t)pos * LDP);
        const u32x4 pl = *(const u32x4*)(zb + (size_t)min(lead, S - 1) * LDP), ptr = *(const u32x4*)(zb + (size_t)max(trail, 0) * LDP);
        const float inv = 1.0f / (float)cnt;
        u32x4 o;
        o.x = cvt_pk_bf16((s[0] * inv - bf_lo(zc.x)) * bf_lo(gt.x), (s[1] * inv - bf_hi(zc.x)) * bf_hi(gt.x));
        o.y = cvt_pk_bf16((s[2] * inv - bf_lo(zc.y)) * bf_lo(gt.y), (s[3] * inv - bf_hi(zc.y)) * bf_hi(gt.y));
        o.z = cvt_pk_bf16((s[4] * inv - bf_lo(zc.z)) * bf_lo(gt.z), (s[5] * inv - bf_hi(zc.z)) * bf_hi(gt.z));
        o.w = cvt_pk_bf16((s[6] * inv - bf_lo(zc.w)) * bf_lo(gt.w), (s[7] * inv - bf_hi(zc.w)) * bf_hi(gt.w));
        *(u32x4*)(yb + (size_t)pos * 1024) = o;
        const bool addl = lead < S, subt = trail >= 0;
        acc8(s, pl, addl ? 1.f : 0.f); acc8(s, ptr, subt ? -1.f : 0.f); cnt += (addl ? 1 : 0) - (subt ? 1 : 0);
    }
}

template <int NS> struct VecN;
template <> struct VecN<8> { typedef u32x4 T; };
template <> struct VecN<4> { typedef u32x2 T; };
__device__ __forceinline__ void unpackN(const u32x4 p, float (&f)[8]) { f[0] = bf_lo(p.x); f[1] = bf_hi(p.x); f[2] = bf_lo(p.y); f[3] = bf_hi(p.y); f[4] = bf_lo(p.z); f[5] = bf_hi(p.z); f[6] = bf_lo(p.w); f[7] = bf_hi(p.w); }
__device__ __forceinline__ void unpackN(const u32x2 p, float (&f)[4]) { f[0] = bf_lo(p.x); f[1] = bf_hi(p.x); f[2] = bf_lo(p.y); f[3] = bf_hi(p.y); }
__device__ __forceinline__ u32x4 packN(const float (&f)[8]) { u32x4 w; w.x = cvt_pk_bf16(f[0], f[1]); w.y = cvt_pk_bf16(f[2], f[3]); w.z = cvt_pk_bf16(f[4], f[5]); w.w = cvt_pk_bf16(f[6], f[7]); return w; }
__device__ __forceinline__ u32x2 packN(const float (&f)[4]) { u32x2 w; w.x = cvt_pk_bf16(f[0], f[1]); w.y = cvt_pk_bf16(f[2], f[3]); return w; }
__device__ __forceinline__ void cmul(float& r, float& i, float cr, float ci) { const float nr = r * cr - i * ci, ni = r * ci + i * cr; r = nr; i = ni; }
template <int R, int NS>
__device__ __forceinline__ void dft1_item(const Ctx& C, int seqtok0, int S, int unit0, int ch, int sb, int k10) {
    typedef typename VecN<NS>::T V;
    constexpr int NH = NS / 2;
    f32x2 a2[R][NH], b2[R][NH];
    {
        V pc[R], ps[R];
        const bf16_t* pcrow = C.PT + (size_t)ch * T_TOK + seqtok0 + NS * sb; const bf16_t* psrow = pcrow + (size_t)256 * T_TOK;
#pragma unroll
        for (int s1 = 0; s1 < R; ++s1) { pc[s1] = *(const V*)(pcrow + 256 * s1); ps[s1] = *(const V*)(psrow + 256 * s1); }
#pragma unroll
        for (int s1 = 0; s1 < R; ++s1) { float a[NS], b[NS]; unpackN(pc[s1], a); unpackN(ps[s1], b);
#pragma unroll
            for (int jj = 0; jj < NH; ++jj) { a2[s1][jj] = (f32x2){a[2 * jj], a[2 * jj + 1]}; b2[s1][jj] = (f32x2){b[2 * jj], b[2 * jj + 1]}; } }
    }
    const float scale = rsqrtf(64.0f * (float)S);
    float w1i, w1r, wki, wkr, m0i, m0r, twi, twr, e1i, e1r, sti, str_;
    sincospif(2.0f / (float)R, &w1i, &w1r); sincospif((float)k10 * (2.0f / (float)R), &wki, &wkr);
    const int s20 = NS * sb;
    sincospif((float)s20 * (2.0f / (float)S), &m0i, &m0r); sincospif((float)((k10 * s20) & (S - 1)) * (2.0f / (float)S), &twi, &twr); twi *= scale; twr *= scale;
    sincospif(2.0f / (float)S, &e1i, &e1r); sincospif((float)k10 * (2.0f / (float)S), &sti, &str_);
#pragma unroll 1
    for (int k1 = k10; k1 < k10 + 8; ++k1) {
        float wr = 1.f, wi = 0.f; f32x2 are[NH], aim[NH];
#pragma unroll
        for (int jj = 0; jj < NH; ++jj) { are[jj] = (f32x2){0.f, 0.f}; aim[jj] = (f32x2){0.f, 0.f}; }
#pragma unroll
        for (int s1 = 0; s1 < R; ++s1) {
#pragma unroll
            for (int jj = 0; jj < NH; ++jj) { are[jj] += a2[s1][jj] * wr - b2[s1][jj] * wi; aim[jj] += b2[s1][jj] * wr + a2[s1][jj] * wi; }
            cmul(wr, wi, wkr, wki);
        }
        float tc = twr, ts = twi, ore[NS], oim[NS];
#pragma unroll
        for (int jj = 0; jj < NH; ++jj) {
            ore[2 * jj] = are[jj].x * tc - aim[jj].x * ts; oim[2 * jj] = are[jj].x * ts + aim[jj].x * tc; cmul(tc, ts, str_, sti);
            ore[2 * jj + 1] = are[jj].y * tc - aim[jj].y * ts; oim[2 * jj + 1] = are[jj].y * ts + aim[jj].y * tc; cmul(tc, ts, str_, sti); }
        bf16_t* ob = C.APT + ((size_t)(unit0 + k1) * 256 + ch) * 512 + s20;
        *(V*)ob = packN(ore); *(V*)(ob + 256) = packN(oim);
        cmul(wkr, wki, w1r, w1i); cmul(twr, twi, m0r, m0i); cmul(str_, sti, e1r, e1i);
    }
}

__device__ __forceinline__ void p2_mixers_ab(const Ctx& C, int l, LAS unsigned char* lds, unsigned* cnt, unsigned nx) {
    const int G = gridDim.x, bid = blockIdx.x;
    if (opaque_tid() < 64) {
        unsigned sp = 0;
        while (__hip_atomic_load(cnt, __ATOMIC_RELAXED, __HIP_MEMORY_SCOPE_AGENT) < nx) { __builtin_amdgcn_s_sleep(2); if (++sp > (1u << 22)) break; }
        __builtin_amdgcn_fence(__ATOMIC_ACQUIRE, "agent");
        asm volatile("s_waitcnt vmcnt(0)" ::: "memory");
    }
    __syncthreads();
    mixer_a_units(C, l, lds);
    const int nlate = (2112 % G == 0) ? 0 : (2112 % G);
    const int vb = bid - nlate, NB = G - nlate;
    if (vb >= 0) { const int gt = vb * 512 + opaque_tid(), NGT = NB * 512; for (int it = gt; it < 1536 * 48; it += NGT) mixer_b_run(C, it); }
}
__device__ __forceinline__ void p2_dft1(const Ctx& C) {
    const int G = gridDim.x, bid = blockIdx.x, tid = opaque_tid();
    const int gt = bid * 512 + tid, NGT = G * 512;
    for (int it = gt; it < 131072; it += NGT) { const int sb = it & 63, ch = (it >> 6) & 255, kh = (it >> 14) & 1, b = it >> 15; dft1_item<16, 4>(C, TP + b * 4096, 4096, 128 + b * 16, ch, sb, 8 * kh); }
    for (int it = gt; it < 131072; it += NGT) { const int sb = it & 31, ch = (it >> 5) & 255, b = it >> 13; dft1_item<8, 8>(C, b * 2048, 2048, b * 8, ch, sb, 0); }
}

__device__ __forceinline__ void unpack8(const u32x4 p, float* f) { f[0] = bf_lo(p.x); f[1] = bf_hi(p.x); f[2] = bf_lo(p.y); f[3] = bf_hi(p.y); f[4] = bf_lo(p.z); f[5] = bf_hi(p.z); f[6] = bf_lo(p.w); f[7] = bf_hi(p.w); }
template <int L>
__device__ __forceinline__ void p5_residual(const Ctx& C) {
    const int tid = opaque_tid(), lane = tid & 63, wave = tid >> 6, G = gridDim.x, bid = blockIdx.x;
    const int gw = bid * 8 + wave, NGW = G * 8;
    const float* pg = C.post_g + L * 1024;
    f32x4 gv[2][2];
#pragma unroll
    for (int j = 0; j < 2; ++j) { gv[j][0] = *(const f32x4*)(pg + 8 * lane + 512 * j); gv[j][1] = *(const f32x4*)(pg + 8 * lane + 512 * j + 4); }
    for (int t2 = gw; t2 < T_TOK / 2; t2 += NGW) {
        const int t = 2 * t2;
        u32x4 yp[2][2]; float x[2][16];
#pragma unroll
        for (int r = 0; r < 2; ++r)
#pragma unroll
            for (int j = 0; j < 2; ++j) yp[r][j] = *(const u32x4*)(C.YO + (size_t)(t + r) * 1024 + 8 * lane + 512 * j);
        {
            u32x4 xp[2][2]; float ri[2];
#pragma unroll
            for (int r = 0; r < 2; ++r) { ri[r] = C.RINV[t + r];
#pragma unroll
                for (int j = 0; j < 2; ++j) xp[r][j] = *(const u32x4*)(C.XB + (size_t)(t + r) * 1024 + 8 * lane + 512 * j); }
#pragma unroll
            for (int r = 0; r < 2; ++r)
#pragma unroll
                for (int j = 0; j < 2; ++j) { unpack8(xp[r][j], &x[r][8 * j]);
#pragma unroll
                    for (int i = 0; i < 8; ++i) x[r][8 * j + i] *= ri[r]; }
        }
        float y[2][16], ss[2];
#pragma unroll
        for (int r = 0; r < 2; ++r) { ss[r] = 0.f;
#pragma unroll
            for (int j = 0; j < 2; ++j) unpack8(yp[r][j], &y[r][8 * j]);
#pragma unroll
            for (int i = 0; i < 16; ++i) ss[r] += y[r][i] * y[r][i]; }
#pragma unroll
        for (int o = 1; o < 64; o <<= 1) { ss[0] += __shfl_xor(ss[0], o); ss[1] += __shfl_xor(ss[1], o); }
        float ss2[2];
#pragma unroll
        for (int r = 0; r < 2; ++r) { const float rr = rsqrtf(ss[r] * (1.0f / 1024.0f) + EPS); ss2[r] = 0.f;
#pragma unroll
            for (int j = 0; j < 2; ++j)
#pragma unroll
                for (int i = 0; i < 8; ++i) { const float gg = (i < 4) ? gv[j][0][i] : gv[j][1][i - 4]; const float o = x[r][8 * j + i] + y[r][8 * j + i] * rr * gg; x[r][8 * j + i] = o; ss2[r] += o * o; } }
        if (L == 0) {
#pragma unroll
            for (int o = 1; o < 64; o <<= 1) { ss2[0] += __shfl_xor(ss2[0], o); ss2[1] += __shfl_xor(ss2[1], o); }
#pragma unroll
            for (int r = 0; r < 2; ++r) { const float ms = ss2[r] * (1.0f / 1024.0f) + EPS; const float r2 = rsqrtf(ms);
                if (lane == 0) C.RINV[t + r] = ms * r2;
#pragma unroll
                for (int j = 0; j < 2; ++j) { u32x4 w; w.x = cvt_pk_bf16(x[r][8 * j + 0] * r2, x[r][8 * j + 1] * r2); w.y = cvt_pk_bf16(x[r][8 * j + 2] * r2, x[r][8 * j + 3] * r2);
                    w.z = cvt_pk_bf16(x[r][8 * j + 4] * r2, x[r][8 * j + 5] * r2); w.w = cvt_pk_bf16(x[r][8 * j + 6] * r2, x[r][8 * j + 7] * r2);
                    *(u32x4*)(C.XB + (size_t)(t + r) * 1024 + 8 * lane + 512 * j) = w; } }
        } else {
#pragma unroll
            for (int r = 0; r < 2; ++r) { float* orow = C.out + (size_t)(t + r) * 1024;
#pragma unroll
                for (int j = 0; j < 2; ++j) { *(f32x4*)(orow + 8 * lane + 512 * j) = (f32x4){x[r][8 * j + 0], x[r][8 * j + 1], x[r][8 * j + 2], x[r][8 * j + 3]};
                    *(f32x4*)(orow + 8 * lane + 512 * j + 4) = (f32x4){x[r][8 * j + 4], x[r][8 * j + 5], x[r][8 * j + 6], x[r][8 * j + 7]}; } }
        }
    }
}

#define XB_TMO      128
#define XB_XCNT(j)  (256  + 64 * (j))
#define XB_XSUB(j)  (1280 + 64 * (j))
#define XB_XGEN(j)  (2304 + 64 * (j))
#define XB_TOP      3328
#define XB_TOPGEN   3392
#define XCD_BAR_WORDS 3456
#define XB_SPIN_CAP (1u << 18)
__device__ __forceinline__ unsigned xb_ld(unsigned* p)              { return __hip_atomic_load(p, __ATOMIC_RELAXED, __HIP_MEMORY_SCOPE_AGENT); }
__device__ __forceinline__ unsigned xb_add(unsigned* p, unsigned v) { return __hip_atomic_fetch_add(p, v, __ATOMIC_RELAXED, __HIP_MEMORY_SCOPE_AGENT); }
__device__ __forceinline__ unsigned xb_xcc_id() { return (unsigned)__builtin_amdgcn_s_getreg((3 << 11) | 20) & 0xFu; }
#define XB_SPIN(cond, bar) do { unsigned _sp = 0; while (cond) { __builtin_amdgcn_s_sleep(1); \
    if ((++_sp & 255u) == 0u) { if (xb_ld(&(bar)[XB_TMO])) break; if (_sp > XB_SPIN_CAP) { atomicAdd(&(bar)[XB_TMO], 1u); break; } } } } while (0)
struct XcdBarrier { unsigned* bar; unsigned x; volatile LAS unsigned* st; };
__device__ __forceinline__ XcdBarrier xcd_barrier_post(unsigned* bar, volatile LAS unsigned* st) {
    XcdBarrier b; b.bar = bar; b.x = xb_xcc_id(); b.st = st;
    if (threadIdx.x == 0) (void)xb_add(&bar[XB_XCNT(b.x)], 1u);
    return b;
}
__device__ __forceinline__ void xcd_barrier_complete(unsigned* bar, unsigned x, unsigned& nloc, unsigned& nx) {
    const unsigned G = gridDim.x * gridDim.y * gridDim.z;
    unsigned sum, cnt, mine, sp = 0u;
    for (;;) {
        sum = 0u; cnt = 0u; mine = 0u;
#pragma unroll
        for (unsigned j = 0; j < 16; ++j) { const unsigned c = xb_ld(&bar[XB_XCNT(j)]); sum += c; cnt += (c > 0u) ? 1u : 0u; mine = (j == x) ? c : mine; }
        if (sum == G) break;
        __builtin_amdgcn_s_sleep(1);
        if ((++sp & 255u) == 0u) { if (xb_ld(&bar[XB_TMO])) break; if (sp > XB_SPIN_CAP) { atomicAdd(&bar[XB_TMO], 1u); break; } }
    }
    nloc = mine > 0u ? mine : 1u; nx = cnt > 0u ? cnt : 1u;
}
__device__ __forceinline__ void xcd_barrier(const XcdBarrier& b) {
    asm volatile("s_waitcnt vmcnt(0)" ::: "memory");
    __syncthreads();
    if (threadIdx.x == 0) {
        unsigned* bar = b.bar;
        __builtin_amdgcn_s_waitcnt(0);
        unsigned nloc = b.st[0], nx = b.st[1];
        if (nloc == 0u) { xcd_barrier_complete(bar, b.x, nloc, nx); b.st[0] = nloc; b.st[1] = nx; }
        const unsigned old = xb_add(&bar[XB_XSUB(b.x)], 1u);
        const unsigned gen = old / nloc;
        if (old + 1u == (gen + 1u) * nloc) {
            __builtin_amdgcn_fence(__ATOMIC_RELEASE, "agent");
            asm volatile("s_waitcnt vmcnt(0)" ::: "memory");
            const unsigned og = xb_add(&bar[XB_TOP], 1u);
            const unsigned tg = og / nx;
            if (og + 1u == (tg + 1u) * nx) xb_add(&bar[XB_TOPGEN], 1u);
            else XB_SPIN(xb_ld(&bar[XB_TOPGEN]) == tg, bar);
            __builtin_amdgcn_fence(__ATOMIC_ACQUIRE, "agent");
            xb_add(&bar[XB_XGEN(b.x)], 1u);
            asm volatile("s_waitcnt vmcnt(0)" ::: "memory");
        } else {
            XB_SPIN(xb_ld(&bar[XB_XGEN(b.x)]) == gen, bar);
            __builtin_amdgcn_fence(__ATOMIC_ACQUIRE, "agent");
            asm volatile("s_waitcnt vmcnt(0)" ::: "memory");
        }
    }
    __syncthreads();
}

__global__ void __launch_bounds__(512, 2) fwd_kernel(Args a) {
    extern __shared__ __attribute__((aligned(16))) unsigned char shm[];
    LAS unsigned char* lds = (LAS unsigned char*)shm;
    cg::grid_group grid = cg::this_grid();
    Ctx C;
    C.xp = a.in[0]; C.xs = a.in[1]; C.pre_g = a.in[2]; C.w_in = a.in[3]; C.a_ln_g = a.in[4]; C.a_ln_b = a.in[5]; C.a_w_s = a.in[6]; C.a_b_s = a.in[7];
    C.b_w = a.in[8]; C.b_scale = a.in[9]; C.c_w = a.in[10]; C.w_out = a.in[11]; C.post_g = a.in[12];
    C.out = a.out;
    C.W1T = (bf16_t*)(a.ws + OFF_W1T); C.WOT = (bf16_t*)(a.ws + OFF_WOT); C.WSB = (bf16_t*)(a.ws + OFF_WSB); C.DQ = (bf16_t*)(a.ws + OFF_DQ);
    C.XB = (bf16_t*)(a.ws + OFF_XB); C.APT = (bf16_t*)(a.ws + OFF_APT); C.RINV = (float*)(a.ws + OFF_RINV); C.PROJ = (bf16_t*)(a.ws + OFF_PROJ); C.PT = (bf16_t*)(a.ws + OFF_PT); C.YO = (bf16_t*)(a.ws + OFF_PROJ); C.YM = (bf16_t*)(a.ws + OFF_YM);
    const int G = gridDim.x, bid = blockIdx.x;
    volatile LAS unsigned* bst = (volatile LAS unsigned*)(lds + 131072);
    if (threadIdx.x < 4) bst[threadIdx.x] = 0u;
    __syncthreads();
    const XcdBarrier xbar = xcd_barrier_post((unsigned*)(a.ws + OFF_BAR), bst);
    for (int pi = a.ph_lo; pi < a.ph_hi; ++pi) {
        const int ph = (PROBE_REPEAT >= 0 && pi > PROBE_REPEAT) ? pi - 1 : pi;
        if (ph == 0) p0_prologue(C, lds);
        else {
            const int l = (ph - 1) / 5, sub = (ph - 1) % 5;
            if (sub == 0) { unsigned* cnt = (unsigned*)(a.ws + OFF_BAR) + 4096 + 2048 * l;     pg8::SchedG1 S; S.init(C.XB, C.W1T + (size_t)l * N1PAD * 1024, G, bid); S.cnt = cnt; S.x = xbar.x; S.nwav = 8u * bst[0]; S.xsub = cnt + 128; const unsigned nx = bst[1]; EpiProj E{C.PROJ, C.PT}; pg8::gemm_phase<GA, GS>(lds, 1024, S, E);
                p2_mixers_ab(C, l, lds, cnt, nx); }
            else if (sub == 1) p2_dft1(C);
            else if (sub == 2) { pg8::Gemm g{C.DQ, C.APT, 256, 192 * 256, 512}; pg8::SchedPlain S; S.init(g, G, bid); EpiDft E{C.PROJ, C.YM}; pg8::gemm_phase<false, GS>(lds, 512, S, E); }
            else if (sub == 3) { pg8::Gemm g{C.YM, C.WOT + (size_t)l * 1024 * 1024, T_TOK, 1024, 1024}; pg8::SchedPlain S; S.init(g, G, bid); EpiY E{C.YO}; pg8::gemm_phase<GA, GS>(lds, 1024, S, E); }
            else { if (l == 0) p5_residual<0>(C); else p5_residual<1>(C); }
        }
        if (pi + 1 < a.ph_hi) { if (a.ph_hi > 1000) grid.sync();   xcd_barrier(xbar); }
    }
}

extern "C" void kernel_launch(void* const* d_in, const int* in_sizes, int n_in, void* d_out, int out_size, void* d_ws, size_t ws_size, hipStream_t stream) {
    static int grid = 0;
    if (grid == 0) {
        if (n_in != 13 || ws_size < WS_END) { fprintf(stderr, "kernel_launch: need 13 inputs and >= %zu bytes of workspace; got n_in %d, ws %zu\n", (size_t)WS_END, n_in, ws_size); grid = -1; return; }
        int dev = 0, cus = 0, per_cu = 0;
        hipGetDevice(&dev); hipDeviceGetAttribute(&cus, hipDeviceAttributeMultiprocessorCount, dev);
        if (hipFuncSetAttribute((const void*)fwd_kernel, hipFuncAttributeMaxDynamicSharedMemorySize, LDS_BYTES) != hipSuccess) { fprintf(stderr, "kernel_launch: hipFuncSetAttribute failed\n"); grid = -1; return; }
        if (hipOccupancyMaxActiveBlocksPerMultiprocessor(&per_cu, (const void*)fwd_kernel, 512, LDS_BYTES) != hipSuccess || per_cu < 1) { fprintf(stderr, "kernel_launch: occupancy query says %d\n", per_cu); per_cu = 1; }
        (void)hipGetLastError();
        grid = cus;
    }
    if (grid < 0) return;
    Args a{};
    for (int i = 0; i < 13; ++i) a.in[i] = (const float*)d_in[i];
    a.out = (float*)d_out; a.ws = (unsigned char*)d_ws;
    if (hipMemsetAsync((char*)d_ws + OFF_BAR, 0, 32768, stream) != hipSuccess) { fprintf(stderr, "kernel_launch: memset failed\n"); return; }
#if N_LAUNCH_MODE == 1
    a.ph_lo = 0; a.ph_hi = 11 + (PROBE_REPEAT >= 0 ? 1 : 0);
    void* args[] = {&a};
    hipError_t e = hipLaunchCooperativeKernel((const void*)fwd_kernel, dim3(grid), dim3(512), args, LDS_BYTES, stream);
    if (e != hipSuccess) fprintf(stderr, "cooperative launch failed: %s (grid %d)\n", hipGetErrorString(e), grid);
#else
    for (int ph = 0; ph < 11; ++ph) { a.ph_lo = ph; a.ph_hi = ph + 1; hipLaunchKernelGGL(fwd_kernel, dim3(grid), dim3(512), LDS_BYTES, stream, a); }
#endif
}
```

```cpp
#include <hip/hip_runtime.h>
#include <hip/hip_cooperative_groups.h>
#include <cstdio>
#include <cstdint>
namespace cg = cooperative_groups;

#ifndef GEMM_ALIGN
#define GEMM_ALIGN true
#endif
#ifndef GEMM_SP2
#define GEMM_SP2 true
#endif
constexpr bool GA = GEMM_ALIGN, GS = GEMM_SP2;
#ifndef PROBE_REPEAT
#define PROBE_REPEAT -1
#endif
#ifndef N_LAUNCH_MODE
#define N_LAUNCH_MODE 1
#endif

#define LAS __attribute__((address_space(3)))
typedef unsigned short bf16_t;
typedef short bf16x8 __attribute__((ext_vector_type(8)));
typedef float f32x4 __attribute__((ext_vector_type(4)));
typedef float f32x2 __attribute__((ext_vector_type(2)));
typedef unsigned u32x4 __attribute__((ext_vector_type(4)));
typedef unsigned u32x2 __attribute__((ext_vector_type(2)));

constexpr int T_TOK = 49152, TP = 32768, DM = 1024, INW = 2432;
constexpr int LDP = 1792;
constexpr int N1PAD = 2816;
constexpr int C_U = 0, C_V = 384, C_BG = 768, C_CG = 1152, C_B = 1408, R_B = 1792, R_PC = 2304, R_PS = 2560;
constexpr float EPS = 1e-6f;
constexpr size_t OFF_W1T = 0;
constexpr size_t OFF_WOT = OFF_W1T + (size_t)2 * N1PAD * 1024 * 2;
constexpr size_t OFF_WSB = OFF_WOT + (size_t)2 * 1024 * 1024 * 2;
constexpr size_t OFF_DQ = OFF_WSB + (size_t)2 * 4 * 128 * 128 * 2;
constexpr size_t OFF_BAR = OFF_DQ + (size_t)256 * 512 * 2;
constexpr size_t OFF_RINV = OFF_BAR + 32768;
constexpr size_t OFF_XB = OFF_RINV + (size_t)T_TOK * 4;
constexpr size_t OFF_PROJ = OFF_XB + (size_t)T_TOK * 1024 * 2;
constexpr size_t OFF_PT = OFF_PROJ + (size_t)T_TOK * LDP * 2;
constexpr size_t OFF_YM = OFF_PT + (size_t)512 * T_TOK * 2;
constexpr size_t OFF_APT = OFF_YM + (size_t)T_TOK * 1024 * 2;
constexpr size_t WS_END = OFF_APT + (size_t)192 * 256 * 512 * 2;
constexpr int LDS_BYTES = 131072 + 64;

struct Args {
    const float* in[13];
    float* out;
    unsigned char* ws;
    int ph_lo, ph_hi;
};

__device__ __forceinline__ unsigned cvt_pk_bf16(float lo, float hi) { unsigned r; asm("v_cvt_pk_bf16_f32 %0, %1, %2" : "=v"(r) : "v"(lo), "v"(hi)); return r; }
__device__ __forceinline__ float bf_lo(unsigned w) { return __uint_as_float(w << 16); }
__device__ __forceinline__ float bf_hi(unsigned w) { return __uint_as_float(w & 0xffff0000u); }
__device__ __forceinline__ float wave_sum(float v) {
#pragma unroll
    for (int o = 1; o < 64; o <<= 1) v += __shfl_xor(v, o);
    return v;
}
__device__ __forceinline__ float sigmoid_fast(float z) { return __builtin_amdgcn_rcpf(1.0f + __builtin_amdgcn_exp2f(-1.4426950409f * z)); }
__device__ __forceinline__ float gelu_tanh(float x) { const float z = 1.5957691216f * (x + 0.044715f * x * x * x); return x * sigmoid_fast(z); }
__device__ __forceinline__ float silu_f(float x) { return x * sigmoid_fast(x); }

__device__ __forceinline__ int opaque_tid() { int t = threadIdx.x; asm volatile("" : "+v"(t)); return t; }
namespace pg8 {
constexpr int BM = 256, BK = 64, HALF = 128, HTB = HALF * BK * 2, STAGE_BYTES = 8 * HTB, NXCD = 8, WGM = 8;
__host__ __device__ __forceinline__ int lds_byte(int r, int c) { const int st = (r >> 4) * 2 + (c >> 5), rr = r & 15, cc = c & 31, ob = rr * 64 + cc * 2; return st * 1024 + (ob ^ (((ob >> 9) & 1) << 5)); }
__host__ __device__ __forceinline__ void stage_rc(int b, int& R, int& C) { const int st = b / 1024, sb = b % 1024, swz = sb ^ (((sb >> 9) & 1) << 5); R = (st >> 1) * 16 + swz / 64; C = (st & 1) * 32 + (swz % 64) / 2; }
__host__ __device__ __forceinline__ int perm32(int rho) { const int n = rho >> 4, i = rho & 15; return 8 * (i >> 2) + 4 * n + (i & 3); }
struct Unit { int pm, pn, kind, flag; const char* A; const char* B; };
struct Gemm { const bf16_t* A; const bf16_t* Bt; int M, N, K; };
struct StaticOrder {
    int nM, nN, nwg, G, c;
    __device__ void init(int M, int N, int G_, int c_) { nM = M / BM; nN = N / BM; nwg = nM * nN; G = G_; c = c_; }
    __device__ bool map(long L, int& pm, int& pn) const {
        if (L >= nwg) return false;
        int wgid = (int)L; { const int q = nwg / NXCD, r = nwg % NXCD, xcd = wgid % NXCD, off = wgid / NXCD; wgid = (xcd < r ? xcd * (q + 1) : r * (q + 1) + (xcd - r) * q) + off; }
        const int nig = WGM * nN, gid = wgid / nig, fm = gid * WGM, gsz = (nM - fm) < WGM ? (nM - fm) : WGM;
        pm = fm + ((wgid % nig) % gsz); pn = (wgid % nig) / gsz; return true;
    }
};
struct SchedPlain {
    StaticOrder o; const char* A; const char* Bt; size_t tstep;
    __device__ void init(const Gemm& g, int G, int c) { o.init(g.M, g.N, G, c); A = (const char*)g.A; Bt = (const char*)g.Bt; tstep = (size_t)256 * g.K * 2; }
    __device__ bool next(int i, Unit& u) const { if (!o.map((long)i * o.G + o.c, u.pm, u.pn)) return false; u.kind = 0; u.flag = 0; u.A = A + (size_t)u.pm * tstep; u.B = Bt + (size_t)u.pn * tstep; return true; }
    __device__ __forceinline__ void done(const Unit&, int) const {}
};
struct SchedG1 {
    StaticOrder o; const char* XB; const char* W; size_t tstep;
    __device__ void init(const bf16_t* xb, const bf16_t* w1t, int G, int c) { o.init(T_TOK, 2304, G, c); XB = (const char*)xb; W = (const char*)w1t; tstep = (size_t)256 * 1024 * 2; }
    unsigned* cnt;
    __device__ bool next(int i, Unit& u) const {
        const long L = (long)i * o.G + o.c;
        if (L < 1728) { o.map(L, u.pm, u.pn); u.kind = 0; u.flag = (L + o.G >= 1728) ? 1 : 0; u.A = XB + (size_t)u.pm * tstep; u.B = W + (size_t)u.pn * tstep; return true; }
        const int idx = (int)(L - 1728); if (idx >= 384) return false;
        u.pm = idx & 1; u.pn = idx >> 1; u.kind = 1; u.flag = 0; u.A = W + (size_t)(9 + u.pm) * tstep; u.B = XB + (size_t)u.pn * tstep; return true;
    }
    unsigned x, nwav, *xsub;
    __device__ __forceinline__ void done(const Unit& u, int lane) const {
        if (u.flag) {
            asm volatile("s_waitcnt vmcnt(0)" ::: "memory");
            if (lane == 0) {
                const unsigned old = __hip_atomic_fetch_add(xsub + 64 * x, 1u, __ATOMIC_RELAXED, __HIP_MEMORY_SCOPE_AGENT);
                if (old + 1u == nwav) {
                    __builtin_amdgcn_fence(__ATOMIC_RELEASE, "agent");
                    asm volatile("s_waitcnt vmcnt(0)" ::: "memory");
                    __hip_atomic_fetch_add(cnt, 1u, __ATOMIC_RELAXED, __HIP_MEMORY_SCOPE_AGENT);
                }
            }
        }
    }
};
template <bool ALIGN_EPI, bool SP2, class Epi, class Sched>
__device__ __forceinline__ void gemm_phase(LAS unsigned char* lds, const int K, const Sched& S, const Epi& E) {
    const int tid = opaque_tid(), wid = __builtin_amdgcn_readfirstlane(tid >> 6), lane = tid & 63, wr = wid >> 2, wc = wid & 3, fr = lane & 15, fq = lane >> 4;
    const int nt = K / BK;
    unsigned voffA[2], voffB[2];
#pragma unroll
    for (int i = 0; i < 2; ++i) { int R, C; stage_rc(tid * 16 + i * 8192, R, C); const int Rb = (R & ~31) + perm32(R & 31);
        voffA[i] = (unsigned)(R * K + C) * 2u; voffB[i] = (unsigned)(Rb * K + C) * 2u; }
    const size_t kstep = (size_t)(BK * 2);
    const size_t hstep = (size_t)HALF * K * 2;
    const unsigned ldsw = (unsigned)wid * 1024u;
    const int aoff = lds_byte(wr * 64 + fr, fq * 8), boff = lds_byte(wc * 32 + fr, fq * 8);
#define PG8_SA(b, h) (((b) * 2 + (h)) * HTB)
#define PG8_SB(b, h) ((4 + (b) * 2 + (h)) * HTB)
#define PG8_STAGE(bufoff, gbase, voff) do { _Pragma("unroll") for (int _i = 0; _i < 2; ++_i) \
        __builtin_amdgcn_global_load_lds((const unsigned*)((const char*)(gbase) + (voff)[_i]), (LAS unsigned*)(lds + (bufoff) + ldsw + _i * 8192), 16, 0, 0); } while (0)
#define PG8_LDA(dst, b, h) do { _Pragma("unroll") for (int m = 0; m < 4; ++m) _Pragma("unroll") for (int k = 0; k < 2; ++k) dst[m][k] = *(const LAS bf16x8*)(lds + PG8_SA(b, h) + aoff + m * 2048 + k * 1024); } while (0)
#define PG8_LDB(dst, b, h) do { _Pragma("unroll") for (int n = 0; n < 2; ++n) _Pragma("unroll") for (int k = 0; k < 2; ++k) dst[n][k] = *(const LAS bf16x8*)(lds + PG8_SB(b, h) + boff + n * 2048 + k * 1024); } while (0)
#define PG8_MMA(ai, bj, At, Bt) do { __builtin_amdgcn_s_setprio(1); _Pragma("unroll") for (int m = 0; m < 4; ++m) _Pragma("unroll") for (int n = 0; n < 2; ++n) _Pragma("unroll") for (int k = 0; k < 2; ++k) \
        acc[ai][bj][m][n] = __builtin_amdgcn_mfma_f32_16x16x32_bf16(Bt[n][k], At[m][k], acc[ai][bj][m][n], 0, 0, 0); __builtin_amdgcn_s_setprio(0); } while (0)
#define PG8_WAIT_V(n) asm volatile("s_waitcnt vmcnt(" #n ")" ::: "memory")
#define PG8_WAIT_L(n) asm volatile("s_waitcnt lgkmcnt(" #n ")" ::: "memory")
#define PG8_BAR __builtin_amdgcn_s_barrier()
#define PG8_SCHED __builtin_amdgcn_sched_barrier(0)
    Unit cur, nxt; int ui = 0;
    if (!S.next(0, cur)) return;
    f32x4 acc[2][2][4][2];
#pragma unroll
    for (int a = 0; a < 2; ++a)
#pragma unroll
        for (int b = 0; b < 2; ++b)
#pragma unroll
            for (int m = 0; m < 4; ++m)
#pragma unroll
                for (int n = 0; n < 2; ++n) acc[a][b][m][n] = (f32x4){0.f, 0.f, 0.f, 0.f};
    bf16x8 At[4][2], B0[2][2], B1[2][2];
    const char* cA = cur.A; const char* cB = cur.B;
    if constexpr (SP2) {
        PG8_STAGE(PG8_SB(0, 0), cB, voffB); PG8_STAGE(PG8_SB(0, 1), cB + hstep, voffB); PG8_STAGE(PG8_SA(0, 0), cA, voffA); PG8_STAGE(PG8_SA(0, 1), cA + hstep, voffA);
        if (wr == 1) PG8_BAR;
        PG8_WAIT_V(2); PG8_BAR;
        PG8_STAGE(PG8_SB(1, 0), cB + kstep, voffB); PG8_STAGE(PG8_SA(1, 0), cA + kstep, voffA); PG8_STAGE(PG8_SB(1, 1), cB + hstep + kstep, voffB);
        PG8_WAIT_V(6); PG8_BAR;
    } else {
    PG8_STAGE(PG8_SB(0, 0), cB, voffB); PG8_STAGE(PG8_SA(0, 0), cA, voffA); PG8_STAGE(PG8_SB(0, 1), cB + hstep, voffB); PG8_STAGE(PG8_SA(0, 1), cA + hstep, voffA);
    if (wr == 1) PG8_BAR;
    PG8_WAIT_V(4); PG8_BAR;
    PG8_STAGE(PG8_SB(1, 0), cB + kstep, voffB); PG8_STAGE(PG8_SA(1, 0), cA + kstep, voffA); PG8_STAGE(PG8_SB(1, 1), cB + hstep + kstep, voffB);
    PG8_WAIT_V(6); PG8_BAR;
    }
    for (;;) {
        const bool has_next = S.next(ui + 1, nxt);
        const char* nA = has_next ? nxt.A : cA; const char* nB = has_next ? nxt.B : cB;
        for (int t = 0; t < nt; t += 2) {
            const bool last = (t == nt - 2);
            const char* a1 = cA + (size_t)(t + 1) * kstep;
            const char* a2 = last ? nA : cA + (size_t)(t + 2) * kstep; const char* b2 = last ? nB : cB + (size_t)(t + 2) * kstep;
            const char* a3 = a2 + kstep; const char* b3 = b2 + kstep;
            if constexpr (SP2) {
            PG8_LDB(B0, 0, 0); PG8_LDB(B1, 0, 1); PG8_SCHED; PG8_LDA(At, 0, 0); PG8_STAGE(PG8_SA(1, 1), a1 + hstep, voffA);
            PG8_WAIT_V(8); PG8_WAIT_L(0); PG8_BAR; PG8_MMA(0, 0, At, B0); PG8_MMA(0, 1, At, B1); PG8_BAR; PG8_SCHED;
            PG8_LDA(At, 0, 1); PG8_STAGE(PG8_SB(0, 0), b2, voffB); PG8_STAGE(PG8_SB(0, 1), b2 + hstep, voffB); PG8_STAGE(PG8_SA(0, 0), a2, voffA);
            PG8_WAIT_V(8); PG8_WAIT_L(0); PG8_BAR; PG8_MMA(1, 0, At, B0); PG8_MMA(1, 1, At, B1); PG8_BAR; PG8_SCHED;
            PG8_LDB(B0, 1, 0); PG8_LDB(B1, 1, 1); PG8_SCHED; PG8_LDA(At, 1, 0); PG8_STAGE(PG8_SA(0, 1), a2 + hstep, voffA);
            PG8_WAIT_V(8); PG8_WAIT_L(0); PG8_BAR; PG8_MMA(0, 0, At, B0); PG8_MMA(0, 1, At, B1); PG8_BAR; PG8_SCHED;
            PG8_LDA(At, 1, 1); PG8_STAGE(PG8_SB(1, 0), b3, voffB); PG8_STAGE(PG8_SB(1, 1), b3 + hstep, voffB); PG8_STAGE(PG8_SA(1, 0), a3, voffA);
            PG8_WAIT_V(8); PG8_WAIT_L(0); PG8_BAR; PG8_MMA(1, 0, At, B0); PG8_MMA(1, 1, At, B1); PG8_BAR; PG8_SCHED;
            } else {
            PG8_LDB(B0, 0, 0); PG8_SCHED; PG8_LDA(At, 0, 0); PG8_STAGE(PG8_SA(1, 1), a1 + hstep, voffA);
            PG8_WAIT_L(8); PG8_BAR; PG8_WAIT_L(0); PG8_MMA(0, 0, At, B0); PG8_BAR; PG8_SCHED;
            PG8_LDB(B1, 0, 1); PG8_STAGE(PG8_SB(0, 0), b2, voffB);
            PG8_BAR; PG8_WAIT_L(0); PG8_MMA(0, 1, At, B1); PG8_BAR;
            PG8_LDA(At, 0, 1); PG8_STAGE(PG8_SA(0, 0), a2, voffA);
            PG8_BAR; PG8_WAIT_L(0); PG8_MMA(1, 0, At, B0); PG8_BAR; PG8_SCHED;
            PG8_STAGE(PG8_SB(0, 1), b2 + hstep, voffB);
            PG8_WAIT_V(6); PG8_BAR; PG8_MMA(1, 1, At, B1); PG8_BAR;
            PG8_LDB(B0, 1, 0); PG8_SCHED; PG8_LDA(At, 1, 0); PG8_STAGE(PG8_SA(0, 1), a2 + hstep, voffA);
            PG8_WAIT_L(8); PG8_BAR; PG8_WAIT_L(0); PG8_MMA(0, 0, At, B0); PG8_BAR; PG8_SCHED;
            PG8_LDB(B1, 1, 1); PG8_STAGE(PG8_SB(1, 0), b3, voffB);
            PG8_BAR; PG8_WAIT_L(0); PG8_MMA(0, 1, At, B1); PG8_BAR;
            PG8_LDA(At, 1, 1); PG8_STAGE(PG8_SA(1, 0), a3, voffA);
            PG8_BAR; PG8_WAIT_L(0); PG8_MMA(1, 0, At, B0); PG8_BAR; PG8_SCHED;
            PG8_STAGE(PG8_SB(1, 1), b3 + hstep, voffB);
            PG8_WAIT_V(6); PG8_BAR; PG8_MMA(1, 1, At, B1); PG8_BAR;
                    }
        }
        if constexpr (ALIGN_EPI) { if (wr == 0) PG8_BAR; }
        E(acc, cur, wr, wc, fr, fq);
        S.done(cur, lane);
        if (!has_next) break;
#pragma unroll
        for (int a = 0; a < 2; ++a)
#pragma unroll
            for (int b = 0; b < 2; ++b)
#pragma unroll
                for (int m = 0; m < 4; ++m)
#pragma unroll
                    for (int n = 0; n < 2; ++n) acc[a][b][m][n] = (f32x4){0.f, 0.f, 0.f, 0.f};
        cur = nxt; cA = nA; cB = nB; ++ui;
        if constexpr (ALIGN_EPI) { if (wr == 1) PG8_BAR; }
    }
    PG8_WAIT_V(0);
    if constexpr (!ALIGN_EPI) { if (wr == 0) PG8_BAR; }
    PG8_BAR;
#undef PG8_SA
#undef PG8_SB
#undef PG8_STAGE
#undef PG8_LDA
#undef PG8_LDB
#undef PG8_MMA
#undef PG8_WAIT_V
#undef PG8_WAIT_L
#undef PG8_BAR
#undef PG8_SCHED
}
}
using pg8::Unit;

template <int ACT> __device__ __forceinline__ float act_f(float x) { if (ACT == 0) return gelu_tanh(x); if (ACT == 1) return silu_f(x); return x; }

struct EpiProj {
    bf16_t* O; bf16_t* PT;
    template <int ACT0, int ACT1> __device__ __forceinline__ void body(const f32x4 (&acc)[2][2][4][2], bf16_t* base, size_t ld, int nbj) const {
#pragma unroll
        for (int ai = 0; ai < 2; ++ai)
#pragma unroll
            for (int m = 0; m < 4; ++m) { bf16_t* rowp = base + (size_t)(ai * 128 + m * 16) * ld;
#pragma unroll
                for (int bj = 0; bj < 2; ++bj) { if (bj < nbj) { const f32x4 v0 = acc[ai][bj][m][0], v1 = acc[ai][bj][m][1]; u32x4 w;
                    if (bj == 0) { w.x = cvt_pk_bf16(act_f<ACT0>(v0[0]), act_f<ACT0>(v0[1])); w.y = cvt_pk_bf16(act_f<ACT0>(v0[2]), act_f<ACT0>(v0[3]));
                        w.z = cvt_pk_bf16(act_f<ACT0>(v1[0]), act_f<ACT0>(v1[1])); w.w = cvt_pk_bf16(act_f<ACT0>(v1[2]), act_f<ACT0>(v1[3])); }
                    else { w.x = cvt_pk_bf16(act_f<ACT1>(v0[0]), act_f<ACT1>(v0[1])); w.y = cvt_pk_bf16(act_f<ACT1>(v0[2]), act_f<ACT1>(v0[3]));
                        w.z = cvt_pk_bf16(act_f<ACT1>(v1[0]), act_f<ACT1>(v1[1])); w.w = cvt_pk_bf16(act_f<ACT1>(v1[2]), act_f<ACT1>(v1[3])); }
                    *(u32x4*)(rowp + bj * 128) = w; } } }
    }
    __device__ __forceinline__ void body_ug(const f32x4 (&acc)[2][2][4][2], bf16_t* base) const {
#pragma unroll
        for (int ai = 0; ai < 2; ++ai)
#pragma unroll
            for (int m = 0; m < 4; ++m) { const f32x4 u0 = acc[ai][0][m][0], u1 = acc[ai][0][m][1], g0 = acc[ai][1][m][0], g1 = acc[ai][1][m][1]; u32x4 w;
                w.x = cvt_pk_bf16(gelu_tanh(u0[0]) * silu_f(g0[0]), gelu_tanh(u0[1]) * silu_f(g0[1])); w.y = cvt_pk_bf16(gelu_tanh(u0[2]) * silu_f(g0[2]), gelu_tanh(u0[3]) * silu_f(g0[3]));
                w.z = cvt_pk_bf16(gelu_tanh(u1[0]) * silu_f(g1[0]), gelu_tanh(u1[1]) * silu_f(g1[1])); w.w = cvt_pk_bf16(gelu_tanh(u1[2]) * silu_f(g1[2]), gelu_tanh(u1[3]) * silu_f(g1[3]));
                *(u32x4*)(base + (size_t)(ai * 128 + m * 16) * LDP) = w; }
    }
    __device__ __forceinline__ void operator()(const f32x4 (&acc)[2][2][4][2], const Unit& u, int wr, int wc, int fr, int fq) const {
        const int row0 = u.pm * 256 + wr * 64 + fr, cw = wc * 32 + 8 * fq;
        if (u.kind == 1) { body<2, 2>(acc, PT + (size_t)row0 * T_TOK + u.pn * 256 + cw, (size_t)T_TOK, 2); return; }
        if (u.pn < 3) { body_ug(acc, O + (size_t)row0 * LDP + u.pn * 128 + cw); return; }
        bf16_t* base = O + (size_t)row0 * LDP + (u.pn * 256 - 384) + cw; const int nbj = (u.pn == 8) ? 1 : 2;
        if (u.pn == 3) body<0, 0>(acc, base, (size_t)LDP, nbj); else if (u.pn == 4) body<0, 1>(acc, base, (size_t)LDP, nbj);
        else if (u.pn < 7) body<1, 1>(acc, base, (size_t)LDP, nbj); else body<2, 2>(acc, base, (size_t)LDP, nbj);
    }
};
struct EpiY {
    bf16_t* O;
    __device__ __forceinline__ void operator()(const f32x4 (&acc)[2][2][4][2], const Unit& u, int wr, int wc, int fr, int fq) const {
        const int row0 = u.pm * 256 + wr * 64 + fr, col0 = u.pn * 256 + wc * 32 + 8 * fq;
#pragma unroll
        for (int ai = 0; ai < 2; ++ai)
#pragma unroll
            for (int m = 0; m < 4; ++m) { bf16_t* rowp = O + (size_t)(row0 + ai * 128 + m * 16) * 1024 + col0;
#pragma unroll
                for (int bj = 0; bj < 2; ++bj) { const f32x4 v0 = acc[ai][bj][m][0], v1 = acc[ai][bj][m][1];
                    u32x4 w; w.x = cvt_pk_bf16(v0[0], v0[1]); w.y = cvt_pk_bf16(v0[2], v0[3]); w.z = cvt_pk_bf16(v1[0], v1[1]); w.w = cvt_pk_bf16(v1[2], v1[3]);
                    *(u32x4*)(rowp + bj * 128) = w; } }
    }
};
struct EpiDft {
    const bf16_t* P; bf16_t* Y;
    __device__ __forceinline__ void operator()(const f32x4 (&acc)[2][2][4][2], const Unit& u, int wr, int wc, int fr, int fq) const {
        const int j = u.pn; int tokbase, k1, R;
        if (j < 128) { tokbase = (j >> 3) * 2048; k1 = j & 7; R = 8; } else { const int jj = j - 128; tokbase = TP + (jj >> 4) * 4096; k1 = jj & 15; R = 16; }
        const int ch0 = wc * 32 + 8 * fq;
#pragma unroll
        for (int ai = 0; ai < 2; ++ai) {
            u32x4 gt[4][2];
#pragma unroll
            for (int m = 0; m < 4; ++m) { const int k2 = ai * 128 + wr * 64 + m * 16 + fr; const size_t tok = (size_t)(tokbase + k1 + R * k2);
#pragma unroll
                for (int bj = 0; bj < 2; ++bj) gt[m][bj] = *(const u32x4*)(P + tok * LDP + C_CG + ch0 + bj * 128); }
#pragma unroll
            for (int m = 0; m < 4; ++m) { const int k2 = ai * 128 + wr * 64 + m * 16 + fr; const size_t tok = (size_t)(tokbase + k1 + R * k2);
#pragma unroll
                for (int bj = 0; bj < 2; ++bj) { const u32x4 g = gt[m][bj];
                    const f32x4 v0 = acc[ai][bj][m][0], v1 = acc[ai][bj][m][1];
                    u32x4 w; w.x = cvt_pk_bf16(v0[0] * bf_lo(g.x), v0[1] * bf_hi(g.x)); w.y = cvt_pk_bf16(v0[2] * bf_lo(g.y), v0[3] * bf_hi(g.y));
                    w.z = cvt_pk_bf16(v1[0] * bf_lo(g.z), v1[1] * bf_hi(g.z)); w.w = cvt_pk_bf16(v1[2] * bf_lo(g.w), v1[3] * bf_hi(g.w));
                    *(u32x4*)(Y + tok * 1024 + 768 + ch0 + bj * 128) = w; } }
        }
    }
};

struct Ctx {
    const float *xp, *xs, *pre_g, *w_in, *a_ln_g, *a_ln_b, *a_w_s, *a_b_s, *b_w, *b_scale, *c_w, *w_out, *post_g;
    float* out;
    bf16_t *W1T, *WOT, *WSB, *DQ, *XB, *APT, *PROJ, *PT, *YO, *YM; float* RINV;
};

__device__ __forceinline__ void transpose_item(const float* W, int ldn, int col0, const float* ks, bf16_t* WT, int row0, int k0, LAS float* scr, int lane) {
    float tv[32];
#pragma unroll
    for (int i = 0; i < 32; ++i) { const int kk = 2 * i + (lane >> 5); tv[i] = W[(size_t)(k0 + kk) * ldn + col0 + (lane & 31)]; }
    if (ks) {
#pragma unroll
        for (int i = 0; i < 32; ++i) tv[i] *= ks[k0 + 2 * i + (lane >> 5)]; }
#pragma unroll
    for (int i = 0; i < 32; ++i) scr[(2 * i + (lane >> 5)) * 33 + (lane & 31)] = tv[i];
    asm volatile("s_waitcnt lgkmcnt(0)" ::: "memory");
    const int c = lane & 7;
#pragma unroll
    for (int j = 0; j < 4; ++j) { const int n = (lane >> 3) + 8 * j; const LAS float* s = scr + (8 * c) * 33 + n;
        u32x4 o; o.x = cvt_pk_bf16(s[0 * 33], s[1 * 33]); o.y = cvt_pk_bf16(s[2 * 33], s[3 * 33]); o.z = cvt_pk_bf16(s[4 * 33], s[5 * 33]); o.w = cvt_pk_bf16(s[6 * 33], s[7 * 33]);
        *(u32x4*)(WT + (size_t)(row0 + n) * 1024 + k0 + 8 * c) = o; }
    asm volatile("s_waitcnt lgkmcnt(0)" ::: "memory");
}

template <int GD, int NP>
__device__ __forceinline__ void fold_compute(const Ctx& C, int l, int k0, int srccol, LAS float* Gm  , LAS float* Ws  , int dst0, int dst1) {
    constexpr int GS = NP + 4, J = NP / 8;
    const int tid = opaque_tid();
    { float wv[64 * GD / 512], pgv[64 * GD / 512];
#pragma unroll
      for (int j = 0; j < 64 * GD / 512; ++j) { const int idx = tid + 512 * j; const int kk = idx / GD, c = idx - kk * GD;
          wv[j] = C.w_in[(size_t)l * 1024 * INW + (size_t)(k0 + kk) * INW + srccol + c]; pgv[j] = C.pre_g[l * 1024 + k0 + kk]; }
#pragma unroll
      for (int j = 0; j < 64 * GD / 512; ++j) { const int idx = tid + 512 * j; const int kk = idx / GD, c = idx - kk * GD; Ws[kk * (GD + 1) + c] = wv[j] * pgv[j]; } }
    __syncthreads();
    const int kk = tid & 63, wv = tid >> 6, n0 = wv * J;
    float acc[J];
#pragma unroll
    for (int j = 0; j < J; ++j) acc[j] = 0.f;
#pragma unroll 4
    for (int c = 0; c < GD; ++c) { const float w = Ws[kk * (GD + 1) + c];
#pragma unroll
        for (int jj = 0; jj < J / 4; ++jj) { const f32x4 g4 = *(const LAS f32x4*)(Gm + c * GS + n0 + 4 * jj);
            acc[4 * jj + 0] += w * g4[0]; acc[4 * jj + 1] += w * g4[1]; acc[4 * jj + 2] += w * g4[2]; acc[4 * jj + 3] += w * g4[3]; } }
    bf16_t* WT = C.W1T + (size_t)l * N1PAD * 1024;
#pragma unroll
    for (int j = 0; j < J; ++j) { const int n = n0 + j; const int row = (NP == 128 && n >= 64) ? (dst1 + n - 64) : (dst0 + n);
        WT[(size_t)row * 1024 + k0 + kk] = (bf16_t)(cvt_pk_bf16(acc[j], 0.f) & 0xffffu); }
    __syncthreads();
}
__device__ __forceinline__ void fold_item(const Ctx& C, int it, LAS unsigned char* lds) {
    const int l = it >> 7, r = it & 127, grp = r >> 4, kb = r & 15, k0 = kb * 64, tid = opaque_tid();
    LAS float* Gm = (LAS float*)lds;
    LAS float* Ws = (LAS float*)(lds + 40960);
    LAS float* Wc = (LAS float*)(lds + 69632);
    LAS float* tb = (LAS float*)(lds + 90112);
    if (grp < 4) {
        const int g = grp;
        { float bw[18], bs[18];
#pragma unroll
          for (int j = 0; j < 18; ++j) { const int idx = tid + 512 * j; const int c = idx / 96, n = idx - c * 96; bw[j] = C.b_w[((size_t)(l * 4 + g) * 96 + c) * 96 + n]; bs[j] = C.b_scale[l * 384 + g * 96 + n]; }
#pragma unroll
          for (int j = 0; j < 18; ++j) { const int idx = tid + 512 * j; const int c = idx / 96, n = idx - c * 96; Gm[c * 100 + n] = bw[j] * bs[j]; } }
        fold_compute<96, 96>(C, l, k0, 1152 + g * 96, Gm, Ws, R_B + g * 96, 0);
    } else {
        const int g = grp - 4;
        if (tid < 64) { float s, c; sincospif((float)tid * (1.0f / 32.0f), &s, &c); tb[tid] = c; tb[64 + tid] = s; }
        { float cw[8];
#pragma unroll
          for (int j = 0; j < 8; ++j) cw[j] = C.c_w[(size_t)(l * 4 + g) * 4096 + tid + 512 * j];
#pragma unroll
          for (int j = 0; j < 8; ++j) { const int idx = tid + 512 * j; Wc[(idx >> 6) * 65 + (idx & 63)] = cw[j]; } }
        __syncthreads();
        for (int idx = tid; idx < 4096; idx += 512) { const int c = idx >> 6, d = idx & 63; float gc = 0.f, gs = 0.f;
#pragma unroll 16
            for (int m = 0; m < 64; ++m) { const float w = Wc[m * 65 + d]; const int ph = (m * c) & 63; gc += tb[ph] * w; gs += tb[64 + ph] * w; }
            Gm[c * 132 + d] = gc; Gm[c * 132 + 64 + d] = gs; }
        fold_compute<64, 128>(C, l, k0, 1920 + g * 64, Gm, Ws, R_PC + g * 64, R_PS + g * 64);
    }
}
__device__ __forceinline__ const float* xrow_ptr(const Ctx& C, int t) { return t < TP ? C.xp + (size_t)t * 1024 : C.xs + (size_t)(t - TP) * 1024; }

__device__ __forceinline__ void weight_prep(const Ctx& C, LAS unsigned char* lds, int l, int vb, int NB) {
    const int tid = opaque_tid(), lane = tid & 63, wave = tid >> 6;
    for (int it = vb; it < 128; it += NB) fold_item(C, l * 128 + it, lds);
    const int gw = vb * 8 + wave, NGW = NB * 8;
    LAS float* scr = (LAS float*)(lds + wave * 8704);
    for (int r = gw; r < 1408; r += NGW) {
        if (r < 896) { const int nb = r >> 4, kb = r & 15, dst = nb * 32;
            int src;
            if (dst < 768) { const int t = dst >> 8, r = dst & 255; src = (r < 128) ? 128 * t + r : 768 + 128 * t + (r - 128); }
            else if (dst < 1152) src = dst - 768 + 384; else if (dst < 1536) src = dst - 1152 + 1536; else src = dst - 1536 + 2176;
            transpose_item(C.w_in + (size_t)l * 1024 * INW, INW, src, C.pre_g + l * 1024, C.W1T + (size_t)l * N1PAD * 1024, dst, kb * 64, scr, lane);
        } else { const int r2 = r - 896; const int nb = r2 >> 4, kb = r2 & 15;
            transpose_item(C.w_out + (size_t)l * 1024 * 1024, 1024, nb * 32, nullptr, C.WOT + (size_t)l * 1024 * 1024, nb * 32, kb * 64, scr, lane); }
    }
    const int gt = vb * 512 + tid, NGT = NB * 512;
    for (int r = gt; r < 128 * 128; r += NGT) *(u32x4*)(C.W1T + (size_t)l * N1PAD * 1024 + (size_t)2176 * 1024 + (size_t)r * 8) = (u32x4){0u, 0u, 0u, 0u};
    for (int i = gt; i < 4 * 128 * 128 / 2; i += NGT) { const size_t e = (size_t)l * 4 * 128 * 128 + 2 * (size_t)i; const f32x2 v = *(const f32x2*)(C.a_w_s + e); *(unsigned*)(C.WSB + e) = cvt_pk_bf16(v.x, v.y); }
}
__device__ __forceinline__ void p0_prologue(const Ctx& C, LAS unsigned char* lds) {
#pragma unroll 1
    for (int l = 0; l < 2; ++l) weight_prep(C, lds, l, (blockIdx.x + 128 * l) % gridDim.x, gridDim.x);
    const int tid = opaque_tid(), lane = tid & 63, wave = tid >> 6, G = gridDim.x, bid = blockIdx.x;
    const int gw = bid * 8 + wave, NGW = G * 8;
    const int gt = bid * 512 + tid, NGT = G * 512;
    for (int i = gt; i < 256 * 512; i += NGT) { const int k2 = i >> 9, jj = i & 511, s2 = jj & 255; const int ph = (k2 * s2) & 255; float s, c; sincospif((float)ph * (1.0f / 128.0f), &s, &c);
        C.DQ[i] = (bf16_t)(cvt_pk_bf16(jj < 256 ? c : -s, 0.f) & 0xffffu); }
    for (int t4 = gw; t4 < T_TOK / 4; t4 += NGW) {
        const f32x4* xr = (const f32x4*)xrow_ptr(C, 4 * t4) + lane; f32x4 v[4][4]; float s[4];
#pragma unroll
        for (int r = 0; r < 4; ++r)
#pragma unroll
            for (int j = 0; j < 4; ++j) v[r][j] = __builtin_nontemporal_load(xr + 256 * r + 64 * j);
#pragma unroll
        for (int r = 0; r < 4; ++r) { s[r] = 0.f;
#pragma unroll
            for (int j = 0; j < 4; ++j) s[r] += (v[r][j].x * v[r][j].x + v[r][j].y * v[r][j].y) + (v[r][j].z * v[r][j].z + v[r][j].w * v[r][j].w); }
#pragma unroll
        for (int o = 1; o < 64; o <<= 1) {
#pragma unroll
            for (int r = 0; r < 4; ++r) s[r] += __shfl_xor(s[r], o); }
        u32x2* op = (u32x2*)(C.XB + (size_t)(4 * t4) * 1024) + lane;
#pragma unroll
        for (int r = 0; r < 4; ++r) { const float ms = s[r] * (1.0f / 1024.0f) + EPS; const float rs = rsqrtf(ms); if (lane == 0) C.RINV[4 * t4 + r] = ms * rs;
#pragma unroll
            for (int j = 0; j < 4; ++j) { u32x2 w; w.x = cvt_pk_bf16(v[r][j].x * rs, v[r][j].y * rs); w.y = cvt_pk_bf16(v[r][j].z * rs, v[r][j].w * rs); op[256 * r + 64 * j] = w; } }
    }
}

constexpr int VSTR = 136;
struct VPre { u32x4 p[3]; };
struct UGPre { u32x2 u[6]; };
__device__ __forceinline__ VPre mixer_a_load_v(const Ctx& C, int unit, int tid) {
    const int c = unit >> 2, h = unit & 3, q = tid >> 2, part = tid & 3;
    const bf16_t* src = C.PROJ + (size_t)(c * 128 + q) * LDP + C_V + h * 96 + part * 24;
    VPre r;
#pragma unroll
    for (int i = 0; i < 3; ++i) r.p[i] = *(const u32x4*)(src + 8 * i);
    return r;
}
__device__ __forceinline__ UGPre mixer_a_load_ug(const Ctx& C, int unit, int w, int fr, int fq) {
    const int c = unit >> 2, h = unit & 3; const size_t tok = (size_t)(c * 128 + 16 * w + fr);
    UGPre r;
#pragma unroll
    for (int nb = 0; nb < 6; ++nb) { const int dc = h * 96 + nb * 16 + 4 * fq; r.u[nb] = *(const u32x2*)(C.PROJ + tok * LDP + C_U + dc); }
    return r;
}
__device__ __forceinline__ void mixer_a_units(const Ctx& C, int l, LAS unsigned char* lds) {
    const int tid = opaque_tid(), lane = tid & 63, w = tid >> 6, fr = lane & 15, fq = lane >> 4, G = gridDim.x;
    LAS bf16_t* vt = (LAS bf16_t*)lds;
    int unit = blockIdx.x;
    if (unit >= 1536) return;
    const int q = tid >> 2, part = tid & 3, d0 = part * 24, p = 16 * w + fr;
    VPre vp = mixer_a_load_v(C, unit, tid);
    UGPre ugn = mixer_a_load_ug(C, unit, w, fr, fq);
    int hcur = -1; float lg[24], lb[24], bias = 0.f; bf16x8 af[4];
    for (; unit < 1536; unit += G) {
        const int c = unit >> 2, h = unit & 3, t0 = c * 128;
        if (h != hcur) {
            hcur = h;
#pragma unroll
            for (int i = 0; i < 24; i += 4) { const f32x4 g4 = *(const f32x4*)(C.a_ln_g + l * 384 + h * 96 + d0 + i), b4 = *(const f32x4*)(C.a_ln_b + l * 384 + h * 96 + d0 + i);
                lg[i] = g4[0]; lg[i + 1] = g4[1]; lg[i + 2] = g4[2]; lg[i + 3] = g4[3]; lb[i] = b4[0]; lb[i + 1] = b4[1]; lb[i + 2] = b4[2]; lb[i + 3] = b4[3]; }
            const bf16_t* wsrow = C.WSB + ((size_t)(l * 4 + h) * 128 + p) * 128 + 8 * fq;
#pragma unroll
            for (int ks = 0; ks < 4; ++ks) af[ks] = *(const bf16x8*)(wsrow + ks * 32);
            bias = C.a_b_s[(l * 4 + h) * 128 + p];
        }
        {
            float v[24];
#pragma unroll
            for (int i = 0; i < 3; ++i) { const u32x4 pk = vp.p[i];
                v[8 * i + 0] = bf_lo(pk.x); v[8 * i + 1] = bf_hi(pk.x); v[8 * i + 2] = bf_lo(pk.y); v[8 * i + 3] = bf_hi(pk.y);
                v[8 * i + 4] = bf_lo(pk.z); v[8 * i + 5] = bf_hi(pk.z); v[8 * i + 6] = bf_lo(pk.w); v[8 * i + 7] = bf_hi(pk.w); }
            float s = 0.f;
#pragma unroll
            for (int i = 0; i < 24; ++i) s += v[i];
            s += __shfl_xor(s, 1); s += __shfl_xor(s, 2);
            const float mean = s * (1.0f / 96.0f); float q2 = 0.f;
#pragma unroll
            for (int i = 0; i < 24; ++i) { v[i] -= mean; q2 += v[i] * v[i]; }
            q2 += __shfl_xor(q2, 1); q2 += __shfl_xor(q2, 2);
            const float rstd = rsqrtf(q2 * (1.0f / 96.0f) + EPS);
            const int qs = q ^ (part << 4);
#pragma unroll
            for (int i = 0; i < 24; ++i) { const float o = v[i] * rstd * lg[i] + lb[i]; vt[(d0 + i) * VSTR + qs] = (bf16_t)(cvt_pk_bf16(o, 0.f) & 0xffffu); }
        }
        const UGPre ug = ugn;
        __syncthreads();
        if (unit + G < 1536) { vp = mixer_a_load_v(C, unit + G, tid); ugn = mixer_a_load_ug(C, unit + G, w, fr, fq); }
        f32x4 acc[6];
#pragma unroll
        for (int nb = 0; nb < 6; ++nb) { acc[nb] = (f32x4){0.f, 0.f, 0.f, 0.f}; const int d = nb * 16 + fr, pr2 = 2 * (d / 24);
#pragma unroll
            for (int ks = 0; ks < 4; ++ks) { const bf16x8 bfr = *(const LAS bf16x8*)(vt + d * VSTR + (((ks * 4 + fq) ^ pr2) << 3));
                acc[nb] = __builtin_amdgcn_mfma_f32_16x16x32_bf16(bfr, af[ks], acc[nb], 0, 0, 0); } }
        const size_t tok = (size_t)(t0 + p);
#pragma unroll
        for (int nb = 0; nb < 6; ++nb) { const int dc = h * 96 + nb * 16 + 4 * fq;
            u32x2 o; o.x = cvt_pk_bf16((acc[nb][0] + bias) * bf_lo(ug.u[nb].x), (acc[nb][1] + bias) * bf_hi(ug.u[nb].x));
            o.y = cvt_pk_bf16((acc[nb][2] + bias) * bf_lo(ug.u[nb].y), (acc[nb][3] + bias) * bf_hi(ug.u[nb].y));
            *(u32x2*)(C.YM + tok * 1024 + dc) = o; }
        __syncthreads();
    }
}

__device__ __forceinline__ void acc8(float (&s)[8], const u32x4 p, float m) {
    s[0] += m * bf_lo(p.x); s[1] += m * bf_hi(p.x); s[2] += m * bf_lo(p.y); s[3] += m * bf_hi(p.y); s[4] += m * bf_lo(p.z); s[5] += m * bf_hi(p.z); s[6] += m * bf_lo(p.w); s[7] += m * bf_hi(p.w);
}
__device__ __forceinline__ void mixer_b_run(const Ctx& C, int item) {
    const int run = item / 48, cb = item - run * 48, g = cb / 12, half = 1 << g, t0 = run * 32;
    int S, pos0;
    if (t0 < TP) { S = 2048; pos0 = t0 & 2047; } else { S = 4096; pos0 = (t0 - TP) & 4095; }
    const bf16_t* zb = C.PROJ + (size_t)(t0 - pos0) * LDP + C_B + cb * 8;
    const bf16_t* gb = C.PROJ + (size_t)(t0 - pos0) * LDP + C_BG + cb * 8;
    bf16_t* yb = C.YM + (size_t)(t0 - pos0) * 1024 + 384 + cb * 8;
    float s[8];
#pragma unroll
    for (int i = 0; i < 8; ++i) s[i] = 0.f;
    int cnt = 0;
#pragma unroll
    for (int d = -8; d < 8; ++d) { const int tau = pos0 + d; const bool ok = (d >= -half) && (d < half) && (tau >= 0) && (tau < S);
        const int tc = min(max(tau, 0), S - 1); const u32x4 p = *(const u32x4*)(zb + (size_t)tc * LDP); acc8(s, p, ok ? 1.f : 0.f); cnt += ok ? 1 : 0; }
#pragma unroll 4
    for (int i = 0; i < 32; ++i) {
        const int pos = pos0 + i, lead = pos + half, trail = pos - half;
        const u32x4 zc = *(const u32x4*)(zb + (size_t)pos * LDP), gt = *(const u32x4*)(gb + (size_t)pos * LDP);
        const u32x4 pl = *(const u32x4*)(zb + (size_t)min(lead, S - 1) * LDP), ptr = *(const u32x4*)(zb + (size_t)max(trail, 0) * LDP);
        const float inv = 1.0f / (float)cnt;
        u32x4 o;
        o.x = cvt_pk_bf16((s[0] * inv - bf_lo(zc.x)) * bf_lo(gt.x), (s[1] * inv - bf_hi(zc.x)) * bf_hi(gt.x));
        o.y = cvt_pk_bf16((s[2] * inv - bf_lo(zc.y)) * bf_lo(gt.y), (s[3] * inv - bf_hi(zc.y)) * bf_hi(gt.y));
        o.z = cvt_pk_bf16((s[4] * inv - bf_lo(zc.z)) * bf_lo(gt.z), (s[5] * inv - bf_hi(zc.z)) * bf_hi(gt.z));
        o.w = cvt_pk_bf16((s[6] * inv - bf_lo(zc.w)) * bf_lo(gt.w), (s[7] * inv - bf_hi(zc.w)) * bf_hi(gt.w));
        *(u32x4*)(yb + (size_t)pos * 1024) = o;
        const bool addl = lead < S, subt = trail >= 0;
        acc8(s, pl, addl ? 1.f : 0.f); acc8(s, ptr, subt ? -1.f : 0.f); cnt += (addl ? 1 : 0) - (subt ? 1 : 0);
    }
}

template <int NS> struct VecN;
template <> struct VecN<8> { typedef u32x4 T; };
template <> struct VecN<4> { typedef u32x2 T; };
__device__ __forceinline__ void unpackN(const u32x4 p, float (&f)[8]) { f[0] = bf_lo(p.x); f[1] = bf_hi(p.x); f[2] = bf_lo(p.y); f[3] = bf_hi(p.y); f[4] = bf_lo(p.z); f[5] = bf_hi(p.z); f[6] = bf_lo(p.w); f[7] = bf_hi(p.w); }
__device__ __forceinline__ void unpackN(const u32x2 p, float (&f)[4]) { f[0] = bf_lo(p.x); f[1] = bf_hi(p.x); f[2] = bf_lo(p.y); f[3] = bf_hi(p.y); }
__device__ __forceinline__ u32x4 packN(const float (&f)[8]) { u32x4 w; w.x = cvt_pk_bf16(f[0], f[1]); w.y = cvt_pk_bf16(f[2], f[3]); w.z = cvt_pk_bf16(f[4], f[5]); w.w = cvt_pk_bf16(f[6], f[7]); return w; }
__device__ __forceinline__ u32x2 packN(const float (&f)[4]) { u32x2 w; w.x = cvt_pk_bf16(f[0], f[1]); w.y = cvt_pk_bf16(f[2], f[3]); return w; }
__device__ __forceinline__ void cmul(float& r, float& i, float cr, float ci) { const float nr = r * cr - i * ci, ni = r * ci + i * cr; r = nr; i = ni; }
template <int R, int NS>
__device__ __forceinline__ void dft1_item(const Ctx& C, int seqtok0, int S, int unit0, int ch, int sb, int k10) {
    typedef typename VecN<NS>::T V;
    constexpr int NH = NS / 2;
    f32x2 a2[R][NH], b2[R][NH];
    {
        V pc[R], ps[R];
        const bf16_t* pcrow = C.PT + (size_t)ch * T_TOK + seqtok0 + NS * sb; const bf16_t* psrow = pcrow + (size_t)256 * T_TOK;
#pragma unroll
        for (int s1 = 0; s1 < R; ++s1) { pc[s1] = *(const V*)(pcrow + 256 * s1); ps[s1] = *(const V*)(psrow + 256 * s1); }
#pragma unroll
        for (int s1 = 0; s1 < R; ++s1) { float a[NS], b[NS]; unpackN(pc[s1], a); unpackN(ps[s1], b);
#pragma unroll
            for (int jj = 0; jj < NH; ++jj) { a2[s1][jj] = (f32x2){a[2 * jj], a[2 * jj + 1]}; b2[s1][jj] = (f32x2){b[2 * jj], b[2 * jj + 1]}; } }
    }
    const float scale = rsqrtf(64.0f * (float)S);
    float w1i, w1r, wki, wkr, m0i, m0r, twi, twr, e1i, e1r, sti, str_;
    sincospif(2.0f / (float)R, &w1i, &w1r); sincospif((float)k10 * (2.0f / (float)R), &wki, &wkr);
    const int s20 = NS * sb;
    sincospif((float)s20 * (2.0f / (float)S), &m0i, &m0r); sincospif((float)((k10 * s20) & (S - 1)) * (2.0f / (float)S), &twi, &twr); twi *= scale; twr *= scale;
    sincospif(2.0f / (float)S, &e1i, &e1r); sincospif((float)k10 * (2.0f / (float)S), &sti, &str_);
#pragma unroll 1
    for (int k1 = k10; k1 < k10 + 8; ++k1) {
        float wr = 1.f, wi = 0.f; f32x2 are[NH], aim[NH];
#pragma unroll
        for (int jj = 0; jj < NH; ++jj) { are[jj] = (f32x2){0.f, 0.f}; aim[jj] = (f32x2){0.f, 0.f}; }
#pragma unroll
        for (int s1 = 0; s1 < R; ++s1) {
#pragma unroll
            for (int jj = 0; jj < NH; ++jj) { are[jj] += a2[s1][jj] * wr - b2[s1][jj] * wi; aim[jj] += b2[s1][jj] * wr + a2[s1][jj] * wi; }
            cmul(wr, wi, wkr, wki);
        }
        float tc = twr, ts = twi, ore[NS], oim[NS];
#pragma unroll
        for (int jj = 0; jj < NH; ++jj) {
            ore[2 * jj] = are[jj].x * tc - aim[jj].x * ts; oim[2 * jj] = are[jj].x * ts + aim[jj].x * tc; cmul(tc, ts, str_, sti);
            ore[2 * jj + 1] = are[jj].y * tc - aim[jj].y * ts; oim[2 * jj + 1] = are[jj].y * ts + aim[jj].y * tc; cmul(tc, ts, str_, sti); }
        bf16_t* ob = C.APT + ((size_t)(unit0 + k1) * 256 + ch) * 512 + s20;
        *(V*)ob = packN(ore); *(V*)(ob + 256) = packN(oim);
        cmul(wkr, wki, w1r, w1i); cmul(twr, twi, m0r, m0i); cmul(str_, sti, e1r, e1i);
    }
}

__device__ __forceinline__ void p2_mixers_ab(const Ctx& C, int l, LAS unsigned char* lds, unsigned* cnt, unsigned nx) {
    const int G = gridDim.x, bid = blockIdx.x;
    if (opaque_tid() < 64) {
        unsigned sp = 0;
        while (__hip_atomic_load(cnt, __ATOMIC_RELAXED, __HIP_MEMORY_SCOPE_AGENT) < nx) { __builtin_amdgcn_s_sleep(2); if (++sp > (1u << 22)) break; }
        __builtin_amdgcn_fence(__ATOMIC_ACQUIRE, "agent");
        asm volatile("s_waitcnt vmcnt(0)" ::: "memory");
    }
    __syncthreads();
    mixer_a_units(C, l, lds);
    const int nlate = (2112 % G == 0) ? 0 : (2112 % G);
    const int vb = bid - nlate, NB = G - nlate;
    if (vb >= 0) { const int gt = vb * 512 + opaque_tid(), NGT = NB * 512; for (int it = gt; it < 1536 * 48; it += NGT) mixer_b_run(C, it); }
}
__device__ __forceinline__ void p2_dft1(const Ctx& C) {
    const int G = gridDim.x, bid = blockIdx.x, tid = opaque_tid();
    const int gt = bid * 512 + tid, NGT = G * 512;
    for (int it = gt; it < 131072; it += NGT) { const int sb = it & 63, ch = (it >> 6) & 255, kh = (it >> 14) & 1, b = it >> 15; dft1_item<16, 4>(C, TP + b * 4096, 4096, 128 + b * 16, ch, sb, 8 * kh); }
    for (int it = gt; it < 131072; it += NGT) { const int sb = it & 31, ch = (it >> 5) & 255, b = it >> 13; dft1_item<8, 8>(C, b * 2048, 2048, b * 8, ch, sb, 0); }
}

__device__ __forceinline__ void unpack8(const u32x4 p, float* f) { f[0] = bf_lo(p.x); f[1] = bf_hi(p.x); f[2] = bf_lo(p.y); f[3] = bf_hi(p.y); f[4] = bf_lo(p.z); f[5] = bf_hi(p.z); f[6] = bf_lo(p.w); f[7] = bf_hi(p.w); }
template <int L>
__device__ __forceinline__ void p5_residual(const Ctx& C) {
    const int tid = opaque_tid(), lane = tid & 63, wave = tid >> 6, G = gridDim.x, bid = blockIdx.x;
    const int gw = bid * 8 + wave, NGW = G * 8;
    const float* pg = C.post_g + L * 1024;
    f32x4 gv[2][2];
#pragma unroll
    for (int j = 0; j < 2; ++j) { gv[j][0] = *(const f32x4*)(pg + 8 * lane + 512 * j); gv[j][1] = *(const f32x4*)(pg + 8 * lane + 512 * j + 4); }
    for (int t2 = gw; t2 < T_TOK / 2; t2 += NGW) {
        const int t = 2 * t2;
        u32x4 yp[2][2]; float x[2][16];
#pragma unroll
        for (int r = 0; r < 2; ++r)
#pragma unroll
            for (int j = 0; j < 2; ++j) yp[r][j] = __builtin_nontemporal_load((const u32x4*)(C.YO + (size_t)(t + r) * 1024 + 8 * lane + 512 * j));
        {
            u32x4 xp[2][2]; float ri[2];
#pragma unroll
            for (int r = 0; r < 2; ++r) { ri[r] = C.RINV[t + r];
#pragma unroll
                for (int j = 0; j < 2; ++j) xp[r][j] = __builtin_nontemporal_load((const u32x4*)(C.XB + (size_t)(t + r) * 1024 + 8 * lane + 512 * j)); }
#pragma unroll
            for (int r = 0; r < 2; ++r)
#pragma unroll
                for (int j = 0; j < 2; ++j) { unpack8(xp[r][j], &x[r][8 * j]);
#pragma unroll
                    for (int i = 0; i < 8; ++i) x[r][8 * j + i] *= ri[r]; }
        }
        float y[2][16], ss[2];
#pragma unroll
        for (int r = 0; r < 2; ++r) { ss[r] = 0.f;
#pragma unroll
            for (int j = 0; j < 2; ++j) unpack8(yp[r][j], &y[r][8 * j]);
#pragma unroll
            for (int i = 0; i < 16; ++i) ss[r] += y[r][i] * y[r][i]; }
#pragma unroll
        for (int o = 1; o < 64; o <<= 1) { ss[0] += __shfl_xor(ss[0], o); ss[1] += __shfl_xor(ss[1], o); }
        float ss2[2];
#pragma unroll
        for (int r = 0; r < 2; ++r) { const float rr = rsqrtf(ss[r] * (1.0f / 1024.0f) + EPS); ss2[r] = 0.f;
#pragma unroll
            for (int j = 0; j < 2; ++j)
#pragma unroll
                for (int i = 0; i < 8; ++i) { const float gg = (i < 4) ? gv[j][0][i] : gv[j][1][i - 4]; const float o = x[r][8 * j + i] + y[r][8 * j + i] * rr * gg; x[r][8 * j + i] = o; ss2[r] += o * o; } }
        if (L == 0) {
#pragma unroll
            for (int o = 1; o < 64; o <<= 1) { ss2[0] += __shfl_xor(ss2[0], o); ss2[1] += __shfl_xor(ss2[1], o); }
#pragma unroll
            for (int r = 0; r < 2; ++r) { const float ms = ss2[r] * (1.0f / 1024.0f) + EPS; const float r2 = rsqrtf(ms);
                if (lane == 0) C.RINV[t + r] = ms * r2;
#pragma unroll
                for (int j = 0; j < 2; ++j) { u32x4 w; w.x = cvt_pk_bf16(x[r][8 * j + 0] * r2, x[r][8 * j + 1] * r2); w.y = cvt_pk_bf16(x[r][8 * j + 2] * r2, x[r][8 * j + 3] * r2);
                    w.z = cvt_pk_bf16(x[r][8 * j + 4] * r2, x[r][8 * j + 5] * r2); w.w = cvt_pk_bf16(x[r][8 * j + 6] * r2, x[r][8 * j + 7] * r2);
                    *(u32x4*)(C.XB + (size_t)(t + r) * 1024 + 8 * lane + 512 * j) = w; } }
        } else {
#pragma unroll
            for (int r = 0; r < 2; ++r) { float* orow = C.out + (size_t)(t + r) * 1024;
#pragma unroll
                for (int j = 0; j < 2; ++j) { *(f32x4*)(orow + 8 * lane + 512 * j) = (f32x4){x[r][8 * j + 0], x[r][8 * j + 1], x[r][8 * j + 2], x[r][8 * j + 3]};
                    *(f32x4*)(orow + 8 * lane + 512 * j + 4) = (f32x4){x[r][8 * j + 4], x[r][8 * j + 5], x[r][8 * j + 6], x[r][8 * j + 7]}; } }
        }
    }
}

#define XB_TMO      128
#define XB_XCNT(j)  (256  + 64 * (j))
#define XB_XSUB(j)  (1280 + 64 * (j))
#define XB_XGEN(j)  (2304 + 64 * (j))
#define XB_TOP      3328
#define XB_TOPGEN   3392
#define XCD_BAR_WORDS 3456
#define XB_SPIN_CAP (1u << 18)
__device__ __forceinline__ unsigned xb_ld(unsigned* p)              { return __hip_atomic_load(p, __ATOMIC_RELAXED, __HIP_MEMORY_SCOPE_AGENT); }
__device__ __forceinline__ unsigned xb_add(unsigned* p, unsigned v) { return __hip_atomic_fetch_add(p, v, __ATOMIC_RELAXED, __HIP_MEMORY_SCOPE_AGENT); }
__device__ __forceinline__ unsigned xb_xcc_id() { return (unsigned)__builtin_amdgcn_s_getreg((3 << 11) | 20) & 0xFu; }
#define XB_SPIN(cond, bar) do { unsigned _sp = 0; while (cond) { __builtin_amdgcn_s_sleep(1); \
    if ((++_sp & 255u) == 0u) { if (xb_ld(&(bar)[XB_TMO])) break; if (_sp > XB_SPIN_CAP) { atomicAdd(&(bar)[XB_TMO], 1u); break; } } } } while (0)
struct XcdBarrier { unsigned* bar; unsigned x; volatile LAS unsigned* st; };
__device__ __forceinline__ XcdBarrier xcd_barrier_post(unsigned* bar, volatile LAS unsigned* st) {
    XcdBarrier b; b.bar = bar; b.x = xb_xcc_id(); b.st = st;
    if (threadIdx.x == 0) (void)xb_add(&bar[XB_XCNT(b.x)], 1u);
    return b;
}
__device__ __forceinline__ void xcd_barrier_complete(unsigned* bar, unsigned x, unsigned& nloc, unsigned& nx) {
    const unsigned G = gridDim.x * gridDim.y * gridDim.z;
    unsigned sum, cnt, mine, sp = 0u;
    for (;;) {
        sum = 0u; cnt = 0u; mine = 0u;
#pragma unroll
        for (unsigned j = 0; j < 16; ++j) { const unsigned c = xb_ld(&bar[XB_XCNT(j)]); sum += c; cnt += (c > 0u) ? 1u : 0u; mine = (j == x) ? c : mine; }
        if (sum == G) break;
        __builtin_amdgcn_s_sleep(1);
        if ((++sp & 255u) == 0u) { if (xb_ld(&bar[XB_TMO])) break; if (sp > XB_SPIN_CAP) { atomicAdd(&bar[XB_TMO], 1u); break; } }
    }
    nloc = mine > 0u ? mine : 1u; nx = cnt > 0u ? cnt : 1u;
}
__device__ __forceinline__ void xcd_barrier(const XcdBarrier& b) {
    asm volatile("s_waitcnt vmcnt(0)" ::: "memory");
    __syncthreads();
    if (threadIdx.x == 0) {
        unsigned* bar = b.bar;
        __builtin_amdgcn_s_waitcnt(0);
        unsigned nloc = b.st[0], nx = b.st[1];
        if (nloc == 0u) { xcd_barrier_complete(bar, b.x, nloc, nx); b.st[0] = nloc; b.st[1] = nx; }
        const unsigned old = xb_add(&bar[XB_XSUB(b.x)], 1u);
        const unsigned gen = old / nloc;
        if (old + 1u == (gen + 1u) * nloc) {
            __builtin_amdgcn_fence(__ATOMIC_RELEASE, "agent");
            asm volatile("s_waitcnt vmcnt(0)" ::: "memory");
            const unsigned og = xb_add(&bar[XB_TOP], 1u);
            const unsigned tg = og / nx;
            if (og + 1u == (tg + 1u) * nx) xb_add(&bar[XB_TOPGEN], 1u);
            else XB_SPIN(xb_ld(&bar[XB_TOPGEN]) == tg, bar);
            __builtin_amdgcn_fence(__ATOMIC_ACQUIRE, "agent");
            xb_add(&bar[XB_XGEN(b.x)], 1u);
            asm volatile("s_waitcnt vmcnt(0)" ::: "memory");
        } else {
            XB_SPIN(xb_ld(&bar[XB_XGEN(b.x)]) == gen, bar);
            __builtin_amdgcn_fence(__ATOMIC_ACQUIRE, "agent");
            asm volatile("s_waitcnt vmcnt(0)" ::: "memory");
        }
    }
    __syncthreads();
}

__global__ void __launch_bounds__(512, 2) fwd_kernel(Args a) {
    extern __shared__ __attribute__((aligned(16))) unsigned char shm[];
    LAS unsigned char* lds = (LAS unsigned char*)shm;
    cg::grid_group grid = cg::this_grid();
    Ctx C;
    C.xp = a.in[0]; C.xs = a.in[1]; C.pre_g = a.in[2]; C.w_in = a.in[3]; C.a_ln_g = a.in[4]; C.a_ln_b = a.in[5]; C.a_w_s = a.in[6]; C.a_b_s = a.in[7];
    C.b_w = a.in[8]; C.b_scale = a.in[9]; C.c_w = a.in[10]; C.w_out = a.in[11]; C.post_g = a.in[12];
    C.out = a.out;
    C.W1T = (bf16_t*)(a.ws + OFF_W1T); C.WOT = (bf16_t*)(a.ws + OFF_WOT); C.WSB = (bf16_t*)(a.ws + OFF_WSB); C.DQ = (bf16_t*)(a.ws + OFF_DQ);
    C.XB = (bf16_t*)(a.ws + OFF_XB); C.APT = (bf16_t*)(a.ws + OFF_APT); C.RINV = (float*)(a.ws + OFF_RINV); C.PROJ = (bf16_t*)(a.ws + OFF_PROJ); C.PT = (bf16_t*)(a.ws + OFF_PT); C.YO = (bf16_t*)(a.ws + OFF_PROJ); C.YM = (bf16_t*)(a.ws + OFF_YM);
    const int G = gridDim.x, bid = blockIdx.x;
    volatile LAS unsigned* bst = (volatile LAS unsigned*)(lds + 131072);
    if (threadIdx.x < 4) bst[threadIdx.x] = 0u;
    __syncthreads();
    const XcdBarrier xbar = xcd_barrier_post((unsigned*)(a.ws + OFF_BAR), bst);
    for (int pi = a.ph_lo; pi < a.ph_hi; ++pi) {
        const int ph = (PROBE_REPEAT >= 0 && pi > PROBE_REPEAT) ? pi - 1 : pi;
        if (ph == 0) p0_prologue(C, lds);
        else {
            const int l = (ph - 1) / 5, sub = (ph - 1) % 5;
            if (sub == 0) { unsigned* cnt = (unsigned*)(a.ws + OFF_BAR) + 4096 + 2048 * l;     pg8::SchedG1 S; S.init(C.XB, C.W1T + (size_t)l * N1PAD * 1024, G, bid); S.cnt = cnt; S.x = xbar.x; S.nwav = 8u * bst[0]; S.xsub = cnt + 128; const unsigned nx = bst[1]; EpiProj E{C.PROJ, C.PT}; pg8::gemm_phase<GA, GS>(lds, 1024, S, E);
                p2_mixers_ab(C, l, lds, cnt, nx); }
            else if (sub == 1) p2_dft1(C);
            else if (sub == 2) { pg8::Gemm g{C.DQ, C.APT, 256, 192 * 256, 512}; pg8::SchedPlain S; S.init(g, G, bid); EpiDft E{C.PROJ, C.YM}; pg8::gemm_phase<false, GS>(lds, 512, S, E); }
            else if (sub == 3) { pg8::Gemm g{C.YM, C.WOT + (size_t)l * 1024 * 1024, T_TOK, 1024, 1024}; pg8::SchedPlain S; S.init(g, G, bid); EpiY E{C.YO}; pg8::gemm_phase<GA, GS>(lds, 1024, S, E); }
            else { if (l == 0) p5_residual<0>(C); else p5_residual<1>(C); }
        }
        if (pi + 1 < a.ph_hi) { if (a.ph_hi > 1000) grid.sync();   xcd_barrier(xbar); }
    }
}

extern "C" void kernel_launch(void* const* d_in, const int* in_sizes, int n_in, void* d_out, int out_size, void* d_ws, size_t ws_size, hipStream_t stream) {
    static int grid = 0;
    if (grid == 0) {
        if (n_in != 13 || ws_size < WS_END) { fprintf(stderr, "kernel_launch: need 13 inputs and >= %zu bytes of workspace; got n_in %d, ws %zu\n", (size_t)WS_END, n_in, ws_size); grid = -1; return; }
        int dev = 0, cus = 0, per_cu = 0;
        hipGetDevice(&dev); hipDeviceGetAttribute(&cus, hipDeviceAttributeMultiprocessorCount, dev);
        if (hipFuncSetAttribute((const void*)fwd_kernel, hipFuncAttributeMaxDynamicSharedMemorySize, LDS_BYTES) != hipSuccess) { fprintf(stderr, "kernel_launch: hipFuncSetAttribute failed\n"); grid = -1; return; }
        if (hipOccupancyMaxActiveBlocksPerMultiprocessor(&per_cu, (const void*)fwd_kernel, 512, LDS_BYTES) != hipSuccess || per_cu < 1) { fprintf(stderr, "kernel_launch: occupancy query says %d\n", per_cu); per_cu = 1; }
        (void)hipGetLastError();
        grid = cus;
    }
    if (grid < 0) return;
    Args a{};
    for (int i = 0; i < 13; ++i) a.in[i] = (const float*)d_in[i];
    a.out = (float*)d_out; a.ws = (unsigned char*)d_ws;
    if (hipMemsetAsync((char*)d_ws + OFF_BAR, 0, 32768, stream) != hipSuccess) { fprintf(stderr, "kernel_launch: memset failed\n"); return; }
#if N_LAUNCH_MODE == 1
    a.ph_lo = 0; a.ph_hi = 11 + (PROBE_REPEAT >= 0 ? 1 : 0);
    void* args[] = {&a};
    hipError_t e = hipLaunchCooperativeKernel((const void*)fwd_kernel, dim3(grid), dim3(512), args, LDS_BYTES, stream);
    if (e != hipSuccess) fprintf(stderr, "cooperative launch failed: %s (grid %d)\n", hipGetErrorString(e), grid);
#else
    for (int ph = 0; ph < 11; ++ph) { a.ph_lo = ph; a.ph_hi = ph + 1; hipLaunchKernelGGL(fwd_kernel, dim3(grid), dim3(512), LDS_BYTES, stream, a); }
#endif
}
```

```cpp
#include <hip/hip_runtime.h>
#include <hip/hip_cooperative_groups.h>
#include <cstdio>
#include <cstdint>
namespace cg = cooperative_groups;

#ifndef GEMM_ALIGN
#define GEMM_ALIGN true
#endif
#ifndef GEMM_SP2
#define GEMM_SP2 true
#endif
constexpr bool GA = GEMM_ALIGN, GS = GEMM_SP2;
#ifndef PROBE_REPEAT
#define PROBE_REPEAT -1
#endif
#ifndef N_LAUNCH_MODE
#define N_LAUNCH_MODE 1
#endif

#define LAS __attribute__((address_space(3)))
typedef unsigned short bf16_t;
typedef short bf16x8 __attribute__((ext_vector_type(8)));
typedef float f32x4 __attribute__((ext_vector_type(4)));
typedef float f32x2 __attribute__((ext_vector_type(2)));
typedef unsigned u32x4 __attribute__((ext_vector_type(4)));
typedef unsigned u32x2 __attribute__((ext_vector_type(2)));

constexpr int T_TOK = 49152, TP = 32768, DM = 1024, INW = 2432;
constexpr int LDP = 1792;
constexpr int N1PAD = 2816;
constexpr int C_U = 0, C_V = 384, C_BG = 768, C_CG = 1152, C_B = 1408, R_B = 1792, R_PC = 2304, R_PS = 2560;
constexpr float EPS = 1e-6f;
constexpr size_t OFF_W1T = 0;
constexpr size_t OFF_WOT = OFF_W1T + (size_t)2 * N1PAD * 1024 * 2;
constexpr size_t OFF_WSB = OFF_WOT + (size_t)2 * 1024 * 1024 * 2;
constexpr size_t OFF_DQ = OFF_WSB + (size_t)2 * 4 * 128 * 128 * 2;
constexpr size_t OFF_BAR = OFF_DQ + (size_t)256 * 512 * 2;
constexpr size_t OFF_RINV = OFF_BAR + 32768;
constexpr size_t OFF_XB = OFF_RINV + (size_t)T_TOK * 4;
constexpr size_t OFF_PROJ = OFF_XB + (size_t)T_TOK * 1024 * 2;
constexpr size_t OFF_PT = OFF_PROJ + (size_t)T_TOK * LDP * 2;
constexpr size_t OFF_YM = OFF_PT + (size_t)512 * T_TOK * 2;
constexpr size_t OFF_APT = OFF_YM + (size_t)T_TOK * 1024 * 2;
constexpr size_t WS_END = OFF_APT + (size_t)192 * 256 * 512 * 2;
constexpr int LDS_BYTES = 131072 + 64;

struct Args {
    const float* in[13];
    float* out;
    unsigned char* ws;
    int ph_lo, ph_hi;
};

__device__ __forceinline__ unsigned cvt_pk_bf16(float lo, float hi) { unsigned r; asm("v_cvt_pk_bf16_f32 %0, %1, %2" : "=v"(r) : "v"(lo), "v"(hi)); return r; }
__device__ __forceinline__ float bf_lo(unsigned w) { return __uint_as_float(w << 16); }
__device__ __forceinline__ float bf_hi(unsigned w) { return __uint_as_float(w & 0xffff0000u); }
__device__ __forceinline__ float wave_sum(float v) {
#pragma unroll
    for (int o = 1; o < 64; o <<= 1) v += __shfl_xor(v, o);
    return v;
}
__device__ __forceinline__ float sigmoid_fast(float z) { return __builtin_amdgcn_rcpf(1.0f + __builtin_amdgcn_exp2f(-1.4426950409f * z)); }
__device__ __forceinline__ float gelu_tanh(float x) { const float z = 1.5957691216f * (x + 0.044715f * x * x * x); return x * sigmoid_fast(z); }
__device__ __forceinline__ float silu_f(float x) { return x * sigmoid_fast(x); }

__device__ __forceinline__ int opaque_tid() { int t = threadIdx.x; asm volatile("" : "+v"(t)); return t; }
namespace pg8 {
constexpr int BM = 256, BK = 64, HALF = 128, HTB = HALF * BK * 2, STAGE_BYTES = 8 * HTB, NXCD = 8, WGM = 8;
__host__ __device__ __forceinline__ int lds_byte(int r, int c) { const int st = (r >> 4) * 2 + (c >> 5), rr = r & 15, cc = c & 31, ob = rr * 64 + cc * 2; return st * 1024 + (ob ^ (((ob >> 9) & 1) << 5)); }
__host__ __device__ __forceinline__ void stage_rc(int b, int& R, int& C) { const int st = b / 1024, sb = b % 1024, swz = sb ^ (((sb >> 9) & 1) << 5); R = (st >> 1) * 16 + swz / 64; C = (st & 1) * 32 + (swz % 64) / 2; }
__host__ __device__ __forceinline__ int perm32(int rho) { const int n = rho >> 4, i = rho & 15; return 8 * (i >> 2) + 4 * n + (i & 3); }
struct Unit { int pm, pn, kind, flag; const char* A; const char* B; };
struct Gemm { const bf16_t* A; const bf16_t* Bt; int M, N, K; };
struct StaticOrder {
    int nM, nN, nwg, G, c;
    __device__ void init(int M, int N, int G_, int c_) { nM = M / BM; nN = N / BM; nwg = nM * nN; G = G_; c = c_; }
    __device__ bool map(long L, int& pm, int& pn) const {
        if (L >= nwg) return false;
        int wgid = (int)L; { const int q = nwg / NXCD, r = nwg % NXCD, xcd = wgid % NXCD, off = wgid / NXCD; wgid = (xcd < r ? xcd * (q + 1) : r * (q + 1) + (xcd - r) * q) + off; }
        const int nig = WGM * nN, gid = wgid / nig, fm = gid * WGM, gsz = (nM - fm) < WGM ? (nM - fm) : WGM;
        pm = fm + ((wgid % nig) % gsz); pn = (wgid % nig) / gsz; return true;
    }
};
struct SchedPlain {
    StaticOrder o; const char* A; const char* Bt; size_t tstep;
    __device__ void init(const Gemm& g, int G, int c) { o.init(g.M, g.N, G, c); A = (const char*)g.A; Bt = (const char*)g.Bt; tstep = (size_t)256 * g.K * 2; }
    __device__ bool next(int i, Unit& u) const { if (!o.map((long)i * o.G + o.c, u.pm, u.pn)) return false; u.kind = 0; u.flag = 0; u.A = A + (size_t)u.pm * tstep; u.B = Bt + (size_t)u.pn * tstep; return true; }
    __device__ __forceinline__ void done(const Unit&, int) const {}
};
struct SchedG1 {
    StaticOrder o; const char* XB; const char* W; size_t tstep;
    __device__ void init(const bf16_t* xb, const bf16_t* w1t, int G, int c) { o.init(T_TOK, 2304, G, c); XB = (const char*)xb; W = (const char*)w1t; tstep = (size_t)256 * 1024 * 2; }
    unsigned* cnt;
    __device__ bool next(int i, Unit& u) const {
        const long L = (long)i * o.G + o.c;
        if (L < 1728) { o.map(L, u.pm, u.pn); u.kind = 0; u.flag = (L + o.G >= 1728) ? 1 : 0; u.A = XB + (size_t)u.pm * tstep; u.B = W + (size_t)u.pn * tstep; return true; }
        const int idx = (int)(L - 1728); if (idx >= 384) return false;
        u.pm = idx & 1; u.pn = idx >> 1; u.kind = 1; u.flag = 0; u.A = W + (size_t)(9 + u.pm) * tstep; u.B = XB + (size_t)u.pn * tstep; return true;
    }
    unsigned x, nwav, *xsub;
    __device__ __forceinline__ void done(const Unit& u, int lane) const {
        if (u.flag) {
            asm volatile("s_waitcnt vmcnt(0)" ::: "memory");
            if (lane == 0) {
                const unsigned old = __hip_atomic_fetch_add(xsub + 64 * x, 1u, __ATOMIC_RELAXED, __HIP_MEMORY_SCOPE_AGENT);
                if (old + 1u == nwav) {
                    __builtin_amdgcn_fence(__ATOMIC_RELEASE, "agent");
                    asm volatile("s_waitcnt vmcnt(0)" ::: "memory");
                    __hip_atomic_fetch_add(cnt, 1u, __ATOMIC_RELAXED, __HIP_MEMORY_SCOPE_AGENT);
                }
            }
        }
    }
};
template <bool ALIGN_EPI, bool SP2, class Epi, class Sched, bool NTB = false>
__device__ __forceinline__ void gemm_phase(LAS unsigned char* lds, const int K, const Sched& S, const Epi& E) {
    const int tid = opaque_tid(), wid = __builtin_amdgcn_readfirstlane(tid >> 6), lane = tid & 63, wr = wid >> 2, wc = wid & 3, fr = lane & 15, fq = lane >> 4;
    const int nt = K / BK;
    unsigned voffA[2], voffB[2];
#pragma unroll
    for (int i = 0; i < 2; ++i) { int R, C; stage_rc(tid * 16 + i * 8192, R, C); const int Rb = (R & ~31) + perm32(R & 31);
        voffA[i] = (unsigned)(R * K + C) * 2u; voffB[i] = (unsigned)(Rb * K + C) * 2u; }
    const size_t kstep = (size_t)(BK * 2);
    const size_t hstep = (size_t)HALF * K * 2;
    const unsigned ldsw = (unsigned)wid * 1024u;
    const int aoff = lds_byte(wr * 64 + fr, fq * 8), boff = lds_byte(wc * 32 + fr, fq * 8);
#define PG8_SA(b, h) (((b) * 2 + (h)) * HTB)
#define PG8_SB(b, h) ((4 + (b) * 2 + (h)) * HTB)
#define PG8_STAGE(bufoff, gbase, voff) do { _Pragma("unroll") for (int _i = 0; _i < 2; ++_i) \
        __builtin_amdgcn_global_load_lds((const unsigned*)((const char*)(gbase) + (voff)[_i]), (LAS unsigned*)(lds + (bufoff) + ldsw + _i * 8192), 16, 0, 0); } while (0)
#define PG8_STAGEB(bufoff, gbase, voff) do { _Pragma("unroll") for (int _i = 0; _i < 2; ++_i) \
        __builtin_amdgcn_global_load_lds((const unsigned*)((const char*)(gbase) + (voff)[_i]), (LAS unsigned*)(lds + (bufoff) + ldsw + _i * 8192), 16, 0, NTB ? 2 : 0); } while (0)
#define PG8_LDA(dst, b, h) do { _Pragma("unroll") for (int m = 0; m < 4; ++m) _Pragma("unroll") for (int k = 0; k < 2; ++k) dst[m][k] = *(const LAS bf16x8*)(lds + PG8_SA(b, h) + aoff + m * 2048 + k * 1024); } while (0)
#define PG8_LDB(dst, b, h) do { _Pragma("unroll") for (int n = 0; n < 2; ++n) _Pragma("unroll") for (int k = 0; k < 2; ++k) dst[n][k] = *(const LAS bf16x8*)(lds + PG8_SB(b, h) + boff + n * 2048 + k * 1024); } while (0)
#define PG8_MMA(ai, bj, At, Bt) do { __builtin_amdgcn_s_setprio(1); _Pragma("unroll") for (int m = 0; m < 4; ++m) _Pragma("unroll") for (int n = 0; n < 2; ++n) _Pragma("unroll") for (int k = 0; k < 2; ++k) \
        acc[ai][bj][m][n] = __builtin_amdgcn_mfma_f32_16x16x32_bf16(Bt[n][k], At[m][k], acc[ai][bj][m][n], 0, 0, 0); __builtin_amdgcn_s_setprio(0); } while (0)
#define PG8_WAIT_V(n) asm volatile("s_waitcnt vmcnt(" #n ")" ::: "memory")
#define PG8_WAIT_L(n) asm volatile("s_waitcnt lgkmcnt(" #n ")" ::: "memory")
#define PG8_BAR __builtin_amdgcn_s_barrier()
#define PG8_SCHED __builtin_amdgcn_sched_barrier(0)
    Unit cur, nxt; int ui = 0;
    if (!S.next(0, cur)) return;
    f32x4 acc[2][2][4][2];
#pragma unroll
    for (int a = 0; a < 2; ++a)
#pragma unroll
        for (int b = 0; b < 2; ++b)
#pragma unroll
            for (int m = 0; m < 4; ++m)
#pragma unroll
                for (int n = 0; n < 2; ++n) acc[a][b][m][n] = (f32x4){0.f, 0.f, 0.f, 0.f};
    bf16x8 At[4][2], B0[2][2], B1[2][2];
    const char* cA = cur.A; const char* cB = cur.B;
    if constexpr (SP2) {
        PG8_STAGEB(PG8_SB(0, 0), cB, voffB); PG8_STAGEB(PG8_SB(0, 1), cB + hstep, voffB); PG8_STAGE(PG8_SA(0, 0), cA, voffA); PG8_STAGE(PG8_SA(0, 1), cA + hstep, voffA);
        if (wr == 1) PG8_BAR;
        PG8_WAIT_V(2); PG8_BAR;
        PG8_STAGEB(PG8_SB(1, 0), cB + kstep, voffB); PG8_STAGE(PG8_SA(1, 0), cA + kstep, voffA); PG8_STAGEB(PG8_SB(1, 1), cB + hstep + kstep, voffB);
        PG8_WAIT_V(6); PG8_BAR;
    } else {
    PG8_STAGEB(PG8_SB(0, 0), cB, voffB); PG8_STAGE(PG8_SA(0, 0), cA, voffA); PG8_STAGEB(PG8_SB(0, 1), cB + hstep, voffB); PG8_STAGE(PG8_SA(0, 1), cA + hstep, voffA);
    if (wr == 1) PG8_BAR;
    PG8_WAIT_V(4); PG8_BAR;
    PG8_STAGEB(PG8_SB(1, 0), cB + kstep, voffB); PG8_STAGE(PG8_SA(1, 0), cA + kstep, voffA); PG8_STAGEB(PG8_SB(1, 1), cB + hstep + kstep, voffB);
    PG8_WAIT_V(6); PG8_BAR;
    }
    for (;;) {
        const bool has_next = S.next(ui + 1, nxt);
        const char* nA = has_next ? nxt.A : cA; const char* nB = has_next ? nxt.B : cB;
        for (int t = 0; t < nt; t += 2) {
            const bool last = (t == nt - 2);
            const char* a1 = cA + (size_t)(t + 1) * kstep;
            const char* a2 = last ? nA : cA + (size_t)(t + 2) * kstep; const char* b2 = last ? nB : cB + (size_t)(t + 2) * kstep;
            const char* a3 = a2 + kstep; const char* b3 = b2 + kstep;
            if constexpr (SP2) {
            PG8_LDB(B0, 0, 0); PG8_LDB(B1, 0, 1); PG8_SCHED; PG8_LDA(At, 0, 0); PG8_STAGE(PG8_SA(1, 1), a1 + hstep, voffA);
            PG8_WAIT_V(8); PG8_WAIT_L(0); PG8_BAR; PG8_MMA(0, 0, At, B0); PG8_MMA(0, 1, At, B1); PG8_BAR; PG8_SCHED;
            PG8_LDA(At, 0, 1); PG8_STAGEB(PG8_SB(0, 0), b2, voffB); PG8_STAGEB(PG8_SB(0, 1), b2 + hstep, voffB); PG8_STAGE(PG8_SA(0, 0), a2, voffA);
            PG8_WAIT_V(8); PG8_WAIT_L(0); PG8_BAR; PG8_MMA(1, 0, At, B0); PG8_MMA(1, 1, At, B1); PG8_BAR; PG8_SCHED;
            PG8_LDB(B0, 1, 0); PG8_LDB(B1, 1, 1); PG8_SCHED; PG8_LDA(At, 1, 0); PG8_STAGE(PG8_SA(0, 1), a2 + hstep, voffA);
            PG8_WAIT_V(8); PG8_WAIT_L(0); PG8_BAR; PG8_MMA(0, 0, At, B0); PG8_MMA(0, 1, At, B1); PG8_BAR; PG8_SCHED;
            PG8_LDA(At, 1, 1); PG8_STAGEB(PG8_SB(1, 0), b3, voffB); PG8_STAGEB(PG8_SB(1, 1), b3 + hstep, voffB); PG8_STAGE(PG8_SA(1, 0), a3, voffA);
            PG8_WAIT_V(8); PG8_WAIT_L(0); PG8_BAR; PG8_MMA(1, 0, At, B0); PG8_MMA(1, 1, At, B1); PG8_BAR; PG8_SCHED;
            } else {
            PG8_LDB(B0, 0, 0); PG8_SCHED; PG8_LDA(At, 0, 0); PG8_STAGE(PG8_SA(1, 1), a1 + hstep, voffA);
            PG8_WAIT_L(8); PG8_BAR; PG8_WAIT_L(0); PG8_MMA(0, 0, At, B0); PG8_BAR; PG8_SCHED;
            PG8_LDB(B1, 0, 1); PG8_STAGEB(PG8_SB(0, 0), b2, voffB);
            PG8_BAR; PG8_WAIT_L(0); PG8_MMA(0, 1, At, B1); PG8_BAR;
            PG8_LDA(At, 0, 1); PG8_STAGE(PG8_SA(0, 0), a2, voffA);
            PG8_BAR; PG8_WAIT_L(0); PG8_MMA(1, 0, At, B0); PG8_BAR; PG8_SCHED;
            PG8_STAGEB(PG8_SB(0, 1), b2 + hstep, voffB);
            PG8_WAIT_V(6); PG8_BAR; PG8_MMA(1, 1, At, B1); PG8_BAR;
            PG8_LDB(B0, 1, 0); PG8_SCHED; PG8_LDA(At, 1, 0); PG8_STAGE(PG8_SA(0, 1), a2 + hstep, voffA);
            PG8_WAIT_L(8); PG8_BAR; PG8_WAIT_L(0); PG8_MMA(0, 0, At, B0); PG8_BAR; PG8_SCHED;
            PG8_LDB(B1, 1, 1); PG8_STAGEB(PG8_SB(1, 0), b3, voffB);
            PG8_BAR; PG8_WAIT_L(0); PG8_MMA(0, 1, At, B1); PG8_BAR;
            PG8_LDA(At, 1, 1); PG8_STAGE(PG8_SA(1, 0), a3, voffA);
            PG8_BAR; PG8_WAIT_L(0); PG8_MMA(1, 0, At, B0); PG8_BAR; PG8_SCHED;
            PG8_STAGEB(PG8_SB(1, 1), b3 + hstep, voffB);
            PG8_WAIT_V(6); PG8_BAR; PG8_MMA(1, 1, At, B1); PG8_BAR;
                    }
        }
        if constexpr (ALIGN_EPI) { if (wr == 0) PG8_BAR; }
        E(acc, cur, wr, wc, fr, fq);
        S.done(cur, lane);
        if (!has_next) break;
#pragma unroll
        for (int a = 0; a < 2; ++a)
#pragma unroll
            for (int b = 0; b < 2; ++b)
#pragma unroll
                for (int m = 0; m < 4; ++m)
#pragma unroll
                    for (int n = 0; n < 2; ++n) acc[a][b][m][n] = (f32x4){0.f, 0.f, 0.f, 0.f};
        cur = nxt; cA = nA; cB = nB; ++ui;
        if constexpr (ALIGN_EPI) { if (wr == 1) PG8_BAR; }
    }
    PG8_WAIT_V(0);
    if constexpr (!ALIGN_EPI) { if (wr == 0) PG8_BAR; }
    PG8_BAR;
#undef PG8_SA
#undef PG8_SB
#undef PG8_STAGE
#undef PG8_STAGEB
#undef PG8_LDA
#undef PG8_LDB
#undef PG8_MMA
#undef PG8_WAIT_V
#undef PG8_WAIT_L
#undef PG8_BAR
#undef PG8_SCHED
}
}
using pg8::Unit;

template <int ACT> __device__ __forceinline__ float act_f(float x) { if (ACT == 0) return gelu_tanh(x); if (ACT == 1) return silu_f(x); return x; }

struct EpiProj {
    bf16_t* O; bf16_t* PT;
    template <int ACT0, int ACT1> __device__ __forceinline__ void body(const f32x4 (&acc)[2][2][4][2], bf16_t* base, size_t ld, int nbj) const {
#pragma unroll
        for (int ai = 0; ai < 2; ++ai)
#pragma unroll
            for (int m = 0; m < 4; ++m) { bf16_t* rowp = base + (size_t)(ai * 128 + m * 16) * ld;
#pragma unroll
                for (int bj = 0; bj < 2; ++bj) { if (bj < nbj) { const f32x4 v0 = acc[ai][bj][m][0], v1 = acc[ai][bj][m][1]; u32x4 w;
                    if (bj == 0) { w.x = cvt_pk_bf16(act_f<ACT0>(v0[0]), act_f<ACT0>(v0[1])); w.y = cvt_pk_bf16(act_f<ACT0>(v0[2]), act_f<ACT0>(v0[3]));
                        w.z = cvt_pk_bf16(act_f<ACT0>(v1[0]), act_f<ACT0>(v1[1])); w.w = cvt_pk_bf16(act_f<ACT0>(v1[2]), act_f<ACT0>(v1[3])); }
                    else { w.x = cvt_pk_bf16(act_f<ACT1>(v0[0]), act_f<ACT1>(v0[1])); w.y = cvt_pk_bf16(act_f<ACT1>(v0[2]), act_f<ACT1>(v0[3]));
                        w.z = cvt_pk_bf16(act_f<ACT1>(v1[0]), act_f<ACT1>(v1[1])); w.w = cvt_pk_bf16(act_f<ACT1>(v1[2]), act_f<ACT1>(v1[3])); }
                    *(u32x4*)(rowp + bj * 128) = w; } } }
    }
    __device__ __forceinline__ void body_ug(const f32x4 (&acc)[2][2][4][2], bf16_t* base) const {
#pragma unroll
        for (int ai = 0; ai < 2; ++ai)
#pragma unroll
            for (int m = 0; m < 4; ++m) { const f32x4 u0 = acc[ai][0][m][0], u1 = acc[ai][0][m][1], g0 = acc[ai][1][m][0], g1 = acc[ai][1][m][1]; u32x4 w;
                w.x = cvt_pk_bf16(gelu_tanh(u0[0]) * silu_f(g0[0]), gelu_tanh(u0[1]) * silu_f(g0[1])); w.y = cvt_pk_bf16(gelu_tanh(u0[2]) * silu_f(g0[2]), gelu_tanh(u0[3]) * silu_f(g0[3]));
                w.z = cvt_pk_bf16(gelu_tanh(u1[0]) * silu_f(g1[0]), gelu_tanh(u1[1]) * silu_f(g1[1])); w.w = cvt_pk_bf16(gelu_tanh(u1[2]) * silu_f(g1[2]), gelu_tanh(u1[3]) * silu_f(g1[3]));
                *(u32x4*)(base + (size_t)(ai * 128 + m * 16) * LDP) = w; }
    }
    __device__ __forceinline__ void operator()(const f32x4 (&acc)[2][2][4][2], const Unit& u, int wr, int wc, int fr, int fq) const {
        const int row0 = u.pm * 256 + wr * 64 + fr, cw = wc * 32 + 8 * fq;
        if (u.kind == 1) { body<2, 2>(acc, PT + (size_t)row0 * T_TOK + u.pn * 256 + cw, (size_t)T_TOK, 2); return; }
        if (u.pn < 3) { body_ug(acc, O + (size_t)row0 * LDP + u.pn * 128 + cw); return; }
        bf16_t* base = O + (size_t)row0 * LDP + (u.pn * 256 - 384) + cw; const int nbj = (u.pn == 8) ? 1 : 2;
        if (u.pn == 3) body<0, 0>(acc, base, (size_t)LDP, nbj); else if (u.pn == 4) body<0, 1>(acc, base, (size_t)LDP, nbj);
        else if (u.pn < 7) body<1, 1>(acc, base, (size_t)LDP, nbj); else body<2, 2>(acc, base, (size_t)LDP, nbj);
    }
};
struct EpiY {
    bf16_t* O;
    __device__ __forceinline__ void operator()(const f32x4 (&acc)[2][2][4][2], const Unit& u, int wr, int wc, int fr, int fq) const {
        const int row0 = u.pm * 256 + wr * 64 + fr, col0 = u.pn * 256 + wc * 32 + 8 * fq;
#pragma unroll
        for (int ai = 0; ai < 2; ++ai)
#pragma unroll
            for (int m = 0; m < 4; ++m) { bf16_t* rowp = O + (size_t)(row0 + ai * 128 + m * 16) * 1024 + col0;
#pragma unroll
                for (int bj = 0; bj < 2; ++bj) { const f32x4 v0 = acc[ai][bj][m][0], v1 = acc[ai][bj][m][1];
                    u32x4 w; w.x = cvt_pk_bf16(v0[0], v0[1]); w.y = cvt_pk_bf16(v0[2], v0[3]); w.z = cvt_pk_bf16(v1[0], v1[1]); w.w = cvt_pk_bf16(v1[2], v1[3]);
                    *(u32x4*)(rowp + bj * 128) = w; } }
    }
};
struct EpiDft {
    const bf16_t* P; bf16_t* Y;
    __device__ __forceinline__ void operator()(const f32x4 (&acc)[2][2][4][2], const Unit& u, int wr, int wc, int fr, int fq) const {
        const int j = u.pn; int tokbase, k1, R;
        if (j < 128) { tokbase = (j >> 3) * 2048; k1 = j & 7; R = 8; } else { const int jj = j - 128; tokbase = TP + (jj >> 4) * 4096; k1 = jj & 15; R = 16; }
        const int ch0 = wc * 32 + 8 * fq;
#pragma unroll
        for (int ai = 0; ai < 2; ++ai) {
            u32x4 gt[4][2];
#pragma unroll
            for (int m = 0; m < 4; ++m) { const int k2 = ai * 128 + wr * 64 + m * 16 + fr; const size_t tok = (size_t)(tokbase + k1 + R * k2);
#pragma unroll
                for (int bj = 0; bj < 2; ++bj) gt[m][bj] = *(const u32x4*)(P + tok * LDP + C_CG + ch0 + bj * 128); }
#pragma unroll
            for (int m = 0; m < 4; ++m) { const int k2 = ai * 128 + wr * 64 + m * 16 + fr; const size_t tok = (size_t)(tokbase + k1 + R * k2);
#pragma unroll
                for (int bj = 0; bj < 2; ++bj) { const u32x4 g = gt[m][bj];
                    const f32x4 v0 = acc[ai][bj][m][0], v1 = acc[ai][bj][m][1];
                    u32x4 w; w.x = cvt_pk_bf16(v0[0] * bf_lo(g.x), v0[1] * bf_hi(g.x)); w.y = cvt_pk_bf16(v0[2] * bf_lo(g.y), v0[3] * bf_hi(g.y));
                    w.z = cvt_pk_bf16(v1[0] * bf_lo(g.z), v1[1] * bf_hi(g.z)); w.w = cvt_pk_bf16(v1[2] * bf_lo(g.w), v1[3] * bf_hi(g.w));
                    *(u32x4*)(Y + tok * 1024 + 768 + ch0 + bj * 128) = w; } }
        }
    }
};

struct Ctx {
    const float *xp, *xs, *pre_g, *w_in, *a_ln_g, *a_ln_b, *a_w_s, *a_b_s, *b_w, *b_scale, *c_w, *w_out, *post_g;
    float* out;
    bf16_t *W1T, *WOT, *WSB, *DQ, *XB, *APT, *PROJ, *PT, *YO, *YM; float* RINV;
};

__device__ __forceinline__ void transpose_item(const float* W, int ldn, int col0, const float* ks, bf16_t* WT, int row0, int k0, LAS float* scr, int lane) {
    float tv[32];
#pragma unroll
    for (int i = 0; i < 32; ++i) { const int kk = 2 * i + (lane >> 5); tv[i] = W[(size_t)(k0 + kk) * ldn + col0 + (lane & 31)]; }
    if (ks) {
#pragma unroll
        for (int i = 0; i < 32; ++i) tv[i] *= ks[k0 + 2 * i + (lane >> 5)]; }
#pragma unroll
    for (int i = 0; i < 32; ++i) scr[(2 * i + (lane >> 5)) * 33 + (lane & 31)] = tv[i];
    asm volatile("s_waitcnt lgkmcnt(0)" ::: "memory");
    const int c = lane & 7;
#pragma unroll
    for (int j = 0; j < 4; ++j) { const int n = (lane >> 3) + 8 * j; const LAS float* s = scr + (8 * c) * 33 + n;
        u32x4 o; o.x = cvt_pk_bf16(s[0 * 33], s[1 * 33]); o.y = cvt_pk_bf16(s[2 * 33], s[3 * 33]); o.z = cvt_pk_bf16(s[4 * 33], s[5 * 33]); o.w = cvt_pk_bf16(s[6 * 33], s[7 * 33]);
        *(u32x4*)(WT + (size_t)(row0 + n) * 1024 + k0 + 8 * c) = o; }
    asm volatile("s_waitcnt lgkmcnt(0)" ::: "memory");
}

template <int GD, int NP>
__device__ __forceinline__ void fold_compute(const Ctx& C, int l, int k0, int srccol, LAS float* Gm  , LAS float* Ws  , int dst0, int dst1) {
    constexpr int GS = NP + 4, J = NP / 8;
    const int tid = opaque_tid();
    { float wv[64 * GD / 512], pgv[64 * GD / 512];
#pragma unroll
      for (int j = 0; j < 64 * GD / 512; ++j) { const int idx = tid + 512 * j; const int kk = idx / GD, c = idx - kk * GD;
          wv[j] = C.w_in[(size_t)l * 1024 * INW + (size_t)(k0 + kk) * INW + srccol + c]; pgv[j] = C.pre_g[l * 1024 + k0 + kk]; }
#pragma unroll
      for (int j = 0; j < 64 * GD / 512; ++j) { const int idx = tid + 512 * j; const int kk = idx / GD, c = idx - kk * GD; Ws[kk * (GD + 1) + c] = wv[j] * pgv[j]; } }
    __syncthreads();
    const int kk = tid & 63, wv = tid >> 6, n0 = wv * J;
    float acc[J];
#pragma unroll
    for (int j = 0; j < J; ++j) acc[j] = 0.f;
#pragma unroll 4
    for (int c = 0; c < GD; ++c) { const float w = Ws[kk * (GD + 1) + c];
#pragma unroll
        for (int jj = 0; jj < J / 4; ++jj) { const f32x4 g4 = *(const LAS f32x4*)(Gm + c * GS + n0 + 4 * jj);
            acc[4 * jj + 0] += w * g4[0]; acc[4 * jj + 1] += w * g4[1]; acc[4 * jj + 2] += w * g4[2]; acc[4 * jj + 3] += w * g4[3]; } }
    bf16_t* WT = C.W1T + (size_t)l * N1PAD * 1024;
#pragma unroll
    for (int j = 0; j < J; ++j) { const int n = n0 + j; const int row = (NP == 128 && n >= 64) ? (dst1 + n - 64) : (dst0 + n);
        WT[(size_t)row * 1024 + k0 + kk] = (bf16_t)(cvt_pk_bf16(acc[j], 0.f) & 0xffffu); }
    __syncthreads();
}
__device__ __forceinline__ void fold_item(const Ctx& C, int it, LAS unsigned char* lds) {
    const int l = it >> 7, r = it & 127, grp = r >> 4, kb = r & 15, k0 = kb * 64, tid = opaque_tid();
    LAS float* Gm = (LAS float*)lds;
    LAS float* Ws = (LAS float*)(lds + 40960);
    LAS float* Wc = (LAS float*)(lds + 69632);
    LAS float* tb = (LAS float*)(lds + 90112);
    if (grp < 4) {
        const int g = grp;
        { float bw[18], bs[18];
#pragma unroll
          for (int j = 0; j < 18; ++j) { const int idx = tid + 512 * j; const int c = idx / 96, n = idx - c * 96; bw[j] = C.b_w[((size_t)(l * 4 + g) * 96 + c) * 96 + n]; bs[j] = C.b_scale[l * 384 + g * 96 + n]; }
#pragma unroll
          for (int j = 0; j < 18; ++j) { const int idx = tid + 512 * j; const int c = idx / 96, n = idx - c * 96; Gm[c * 100 + n] = bw[j] * bs[j]; } }
        fold_compute<96, 96>(C, l, k0, 1152 + g * 96, Gm, Ws, R_B + g * 96, 0);
    } else {
        const int g = grp - 4;
        if (tid < 64) { float s, c; sincospif((float)tid * (1.0f / 32.0f), &s, &c); tb[tid] = c; tb[64 + tid] = s; }
        { float cw[8];
#pragma unroll
          for (int j = 0; j < 8; ++j) cw[j] = C.c_w[(size_t)(l * 4 + g) * 4096 + tid + 512 * j];
#pragma unroll
          for (int j = 0; j < 8; ++j) { const int idx = tid + 512 * j; Wc[(idx >> 6) * 65 + (idx & 63)] = cw[j]; } }
        __syncthreads();
        for (int idx = tid; idx < 4096; idx += 512) { const int c = idx >> 6, d = idx & 63; float gc = 0.f, gs = 0.f;
#pragma unroll 16
            for (int m = 0; m < 64; ++m) { const float w = Wc[m * 65 + d]; const int ph = (m * c) & 63; gc += tb[ph] * w; gs += tb[64 + ph] * w; }
            Gm[c * 132 + d] = gc; Gm[c * 132 + 64 + d] = gs; }
        fold_compute<64, 128>(C, l, k0, 1920 + g * 64, Gm, Ws, R_PC + g * 64, R_PS + g * 64);
    }
}
__device__ __forceinline__ const float* xrow_ptr(const Ctx& C, int t) { return t < TP ? C.xp + (size_t)t * 1024 : C.xs + (size_t)(t - TP) * 1024; }

__device__ __forceinline__ void weight_prep(const Ctx& C, LAS unsigned char* lds, int l, int vb, int NB) {
    const int tid = opaque_tid(), lane = tid & 63, wave = tid >> 6;
    for (int it = vb; it < 128; it += NB) fold_item(C, l * 128 + it, lds);
    const int gw = vb * 8 + wave, NGW = NB * 8;
    LAS float* scr = (LAS float*)(lds + wave * 8704);
    for (int r = gw; r < 1408; r += NGW) {
        if (r < 896) { const int nb = r >> 4, kb = r & 15, dst = nb * 32;
            int src;
            if (dst < 768) { const int t = dst >> 8, r = dst & 255; src = (r < 128) ? 128 * t + r : 768 + 128 * t + (r - 128); }
            else if (dst < 1152) src = dst - 768 + 384; else if (dst < 1536) src = dst - 1152 + 1536; else src = dst - 1536 + 2176;
            transpose_item(C.w_in + (size_t)l * 1024 * INW, INW, src, C.pre_g + l * 1024, C.W1T + (size_t)l * N1PAD * 1024, dst, kb * 64, scr, lane);
        } else { const int r2 = r - 896; const int nb = r2 >> 4, kb = r2 & 15;
            transpose_item(C.w_out + (size_t)l * 1024 * 1024, 1024, nb * 32, nullptr, C.WOT + (size_t)l * 1024 * 1024, nb * 32, kb * 64, scr, lane); }
    }
    const int gt = vb * 512 + tid, NGT = NB * 512;
    for (int r = gt; r < 128 * 128; r += NGT) *(u32x4*)(C.W1T + (size_t)l * N1PAD * 1024 + (size_t)2176 * 1024 + (size_t)r * 8) = (u32x4){0u, 0u, 0u, 0u};
    for (int i = gt; i < 4 * 128 * 128 / 2; i += NGT) { const size_t e = (size_t)l * 4 * 128 * 128 + 2 * (size_t)i; const f32x2 v = *(const f32x2*)(C.a_w_s + e); *(unsigned*)(C.WSB + e) = cvt_pk_bf16(v.x, v.y); }
}
__device__ __forceinline__ void p0_prologue(const Ctx& C, LAS unsigned char* lds) {
#pragma unroll 1
    for (int l = 0; l < 2; ++l) weight_prep(C, lds, l, (blockIdx.x + 128 * l) % gridDim.x, gridDim.x);
    const int tid = opaque_tid(), lane = tid & 63, wave = tid >> 6, G = gridDim.x, bid = blockIdx.x;
    const int gw = bid * 8 + wave, NGW = G * 8;
    const int gt = bid * 512 + tid, NGT = G * 512;
    for (int i = gt; i < 256 * 512; i += NGT) { const int k2 = i >> 9, jj = i & 511, s2 = jj & 255; const int ph = (k2 * s2) & 255; float s, c; sincospif((float)ph * (1.0f / 128.0f), &s, &c);
        C.DQ[i] = (bf16_t)(cvt_pk_bf16(jj < 256 ? c : -s, 0.f) & 0xffffu); }
    for (int t4 = gw; t4 < T_TOK / 4; t4 += NGW) {
        const f32x4* xr = (const f32x4*)xrow_ptr(C, 4 * t4) + lane; f32x4 v[4][4]; float s[4];
#pragma unroll
        for (int r = 0; r < 4; ++r)
#pragma unroll
            for (int j = 0; j < 4; ++j) v[r][j] = __builtin_nontemporal_load(xr + 256 * r + 64 * j);
#pragma unroll
        for (int r = 0; r < 4; ++r) { s[r] = 0.f;
#pragma unroll
            for (int j = 0; j < 4; ++j) s[r] += (v[r][j].x * v[r][j].x + v[r][j].y * v[r][j].y) + (v[r][j].z * v[r][j].z + v[r][j].w * v[r][j].w); }
#pragma unroll
        for (int o = 1; o < 64; o <<= 1) {
#pragma unroll
            for (int r = 0; r < 4; ++r) s[r] += __shfl_xor(s[r], o); }
        u32x2* op = (u32x2*)(C.XB + (size_t)(4 * t4) * 1024) + lane;
#pragma unroll
        for (int r = 0; r < 4; ++r) { const float ms = s[r] * (1.0f / 1024.0f) + EPS; const float rs = rsqrtf(ms); if (lane == 0) C.RINV[4 * t4 + r] = ms * rs;
#pragma unroll
            for (int j = 0; j < 4; ++j) { u32x2 w; w.x = cvt_pk_bf16(v[r][j].x * rs, v[r][j].y * rs); w.y = cvt_pk_bf16(v[r][j].z * rs, v[r][j].w * rs); op[256 * r + 64 * j] = w; } }
    }
}

constexpr int VSTR = 136;
struct VPre { u32x4 p[3]; };
struct UGPre { u32x2 u[6]; };
__device__ __forceinline__ VPre mixer_a_load_v(const Ctx& C, int unit, int tid) {
    const int c = unit >> 2, h = unit & 3, q = tid >> 2, part = tid & 3;
    const bf16_t* src = C.PROJ + (size_t)(c * 128 + q) * LDP + C_V + h * 96 + part * 24;
    VPre r;
#pragma unroll
    for (int i = 0; i < 3; ++i) r.p[i] = *(const u32x4*)(src + 8 * i);
    return r;
}
__device__ __forceinline__ UGPre mixer_a_load_ug(const Ctx& C, int unit, int w, int fr, int fq) {
    const int c = unit >> 2, h = unit & 3; const size_t tok = (size_t)(c * 128 + 16 * w + fr);
    UGPre r;
#pragma unroll
    for (int nb = 0; nb < 6; ++nb) { const int dc = h * 96 + nb * 16 + 4 * fq; r.u[nb] = *(const u32x2*)(C.PROJ + tok * LDP + C_U + dc); }
    return r;
}
__device__ __forceinline__ void mixer_a_units(const Ctx& C, int l, LAS unsigned char* lds) {
    const int tid = opaque_tid(), lane = tid & 63, w = tid >> 6, fr = lane & 15, fq = lane >> 4, G = gridDim.x;
    LAS bf16_t* vt = (LAS bf16_t*)lds;
    int unit = blockIdx.x;
    if (unit >= 1536) return;
    const int q = tid >> 2, part = tid & 3, d0 = part * 24, p = 16 * w + fr;
    VPre vp = mixer_a_load_v(C, unit, tid);
    UGPre ugn = mixer_a_load_ug(C, unit, w, fr, fq);
    int hcur = -1; float lg[24], lb[24], bias = 0.f; bf16x8 af[4];
    for (; unit < 1536; unit += G) {
        const int c = unit >> 2, h = unit & 3, t0 = c * 128;
        if (h != hcur) {
            hcur = h;
#pragma unroll
            for (int i = 0; i < 24; i += 4) { const f32x4 g4 = *(const f32x4*)(C.a_ln_g + l * 384 + h * 96 + d0 + i), b4 = *(const f32x4*)(C.a_ln_b + l * 384 + h * 96 + d0 + i);
                lg[i] = g4[0]; lg[i + 1] = g4[1]; lg[i + 2] = g4[2]; lg[i + 3] = g4[3]; lb[i] = b4[0]; lb[i + 1] = b4[1]; lb[i + 2] = b4[2]; lb[i + 3] = b4[3]; }
            const bf16_t* wsrow = C.WSB + ((size_t)(l * 4 + h) * 128 + p) * 128 + 8 * fq;
#pragma unroll
            for (int ks = 0; ks < 4; ++ks) af[ks] = *(const bf16x8*)(wsrow + ks * 32);
            bias = C.a_b_s[(l * 4 + h) * 128 + p];
        }
        {
            float v[24];
#pragma unroll
            for (int i = 0; i < 3; ++i) { const u32x4 pk = vp.p[i];
                v[8 * i + 0] = bf_lo(pk.x); v[8 * i + 1] = bf_hi(pk.x); v[8 * i + 2] = bf_lo(pk.y); v[8 * i + 3] = bf_hi(pk.y);
                v[8 * i + 4] = bf_lo(pk.z); v[8 * i + 5] = bf_hi(pk.z); v[8 * i + 6] = bf_lo(pk.w); v[8 * i + 7] = bf_hi(pk.w); }
            float s = 0.f;
#pragma unroll
            for (int i = 0; i < 24; ++i) s += v[i];
            s += __shfl_xor(s, 1); s += __shfl_xor(s, 2);
            const float mean = s * (1.0f / 96.0f); float q2 = 0.f;
#pragma unroll
            for (int i = 0; i < 24; ++i) { v[i] -= mean; q2 += v[i] * v[i]; }
            q2 += __shfl_xor(q2, 1); q2 += __shfl_xor(q2, 2);
            const float rstd = rsqrtf(q2 * (1.0f / 96.0f) + EPS);
            const int qs = q ^ (part << 4);
#pragma unroll
            for (int i = 0; i < 24; ++i) { const float o = v[i] * rstd * lg[i] + lb[i]; vt[(d0 + i) * VSTR + qs] = (bf16_t)(cvt_pk_bf16(o, 0.f) & 0xffffu); }
        }
        const UGPre ug = ugn;
        __syncthreads();
        if (unit + G < 1536) { vp = mixer_a_load_v(C, unit + G, tid); ugn = mixer_a_load_ug(C, unit + G, w, fr, fq); }
        f32x4 acc[6];
#pragma unroll
        for (int nb = 0; nb < 6; ++nb) { acc[nb] = (f32x4){0.f, 0.f, 0.f, 0.f}; const int d = nb * 16 + fr, pr2 = 2 * (d / 24);
#pragma unroll
            for (int ks = 0; ks < 4; ++ks) { const bf16x8 bfr = *(const LAS bf16x8*)(vt + d * VSTR + (((ks * 4 + fq) ^ pr2) << 3));
                acc[nb] = __builtin_amdgcn_mfma_f32_16x16x32_bf16(bfr, af[ks], acc[nb], 0, 0, 0); } }
        const size_t tok = (size_t)(t0 + p);
#pragma unroll
        for (int nb = 0; nb < 6; ++nb) { const int dc = h * 96 + nb * 16 + 4 * fq;
            u32x2 o; o.x = cvt_pk_bf16((acc[nb][0] + bias) * bf_lo(ug.u[nb].x), (acc[nb][1] + bias) * bf_hi(ug.u[nb].x));
            o.y = cvt_pk_bf16((acc[nb][2] + bias) * bf_lo(ug.u[nb].y), (acc[nb][3] + bias) * bf_hi(ug.u[nb].y));
            *(u32x2*)(C.YM + tok * 1024 + dc) = o; }
        __syncthreads();
    }
}

__device__ __forceinline__ void acc8(float (&s)[8], const u32x4 p, float m) {
    s[0] += m * bf_lo(p.x); s[1] += m * bf_hi(p.x); s[2] += m * bf_lo(p.y); s[3] += m * bf_hi(p.y); s[4] += m * bf_lo(p.z); s[5] += m * bf_hi(p.z); s[6] += m * bf_lo(p.w); s[7] += m * bf_hi(p.w);
}
__device__ __forceinline__ void mixer_b_run(const Ctx& C, int item) {
    const int run = item / 48, cb = item - run * 48, g = cb / 12, half = 1 << g, t0 = run * 32;
    int S, pos0;
    if (t0 < TP) { S = 2048; pos0 = t0 & 2047; } else { S = 4096; pos0 = (t0 - TP) & 4095; }
    const bf16_t* zb = C.PROJ + (size_t)(t0 - pos0) * LDP + C_B + cb * 8;
    const bf16_t* gb = C.PROJ + (size_t)(t0 - pos0) * LDP + C_BG + cb * 8;
    bf16_t* yb = C.YM + (size_t)(t0 - pos0) * 1024 + 384 + cb * 8;
    float s[8];
#pragma unroll
    for (int i = 0; i < 8; ++i) s[i] = 0.f;
    int cnt = 0;
#pragma unroll
    for (int d = -8; d < 8; ++d) { const int tau = pos0 + d; const bool ok = (d >= -half) && (d < half) && (tau >= 0) && (tau < S);
        const int tc = min(max(tau, 0), S - 1); const u32x4 p = *(const u32x4*)(zb + (size_t)tc * LDP); acc8(s, p, ok ? 1.f : 0.f); cnt += ok ? 1 : 0; }
#pragma unroll 4
    for (int i = 0; i < 32; ++i) {
        const int pos = pos0 + i, lead = pos + half, trail = pos - half;
        const u32x4 zc = *(const u32x4*)(zb + (size_t)pos * LDP), gt = *(const u32x4*)(gb + (size_t)pos * LDP);
        const u32x4 pl = *(const u32x4*)(zb + (size_t)min(lead, S - 1) * LDP), ptr = *(const u32x4*)(zb + (size_t)max(trail, 0) * LDP);
        const float inv = 1.0f / (float)cnt;
        u32x4 o;
        o.x = cvt_pk_bf16((s[0] * inv - bf_lo(zc.x)) * bf_lo(gt.x), (s[1] * inv - bf_hi(zc.x)) * bf_hi(gt.x));
        o.y = cvt_pk_bf16((s[2] * inv - bf_lo(zc.y)) * bf_lo(gt.y), (s[3] * inv - bf_hi(zc.y)) * bf_hi(gt.y));
        o.z = cvt_pk_bf16((s[4] * inv - bf_lo(zc.z)) * bf_lo(gt.z), (s[5] * inv - bf_hi(zc.z)) * bf_hi(gt.z));
        o.w = cvt_pk_bf16((s[6] * inv - bf_lo(zc.w)) * bf_lo(gt.w), (s[7] * inv - bf_hi(zc.w)) * bf_hi(gt.w));
        *(u32x4*)(yb + (size_t)pos * 1024) = o;
        const bool addl = lead < S, subt = trail >= 0;
        acc8(s, pl, addl ? 1.f : 0.f); acc8(s, ptr, subt ? -1.f : 0.f); cnt += (addl ? 1 : 0) - (subt ? 1 : 0);
    }
}

template <int NS> struct VecN;
template <> struct VecN<8> { typedef u32x4 T; };
template <> struct VecN<4> { typedef u32x2 T; };
__device__ __forceinline__ void unpackN(const u32x4 p, float (&f)[8]) { f[0] = bf_lo(p.x); f[1] = bf_hi(p.x); f[2] = bf_lo(p.y); f[3] = bf_hi(p.y); f[4] = bf_lo(p.z); f[5] = bf_hi(p.z); f[6] = bf_lo(p.w); f[7] = bf_hi(p.w); }
__device__ __forceinline__ void unpackN(const u32x2 p, float (&f)[4]) { f[0] = bf_lo(p.x); f[1] = bf_hi(p.x); f[2] = bf_lo(p.y); f[3] = bf_hi(p.y); }
__device__ __forceinline__ u32x4 packN(const float (&f)[8]) { u32x4 w; w.x = cvt_pk_bf16(f[0], f[1]); w.y = cvt_pk_bf16(f[2], f[3]); w.z = cvt_pk_bf16(f[4], f[5]); w.w = cvt_pk_bf16(f[6], f[7]); return w; }
__device__ __forceinline__ u32x2 packN(const float (&f)[4]) { u32x2 w; w.x = cvt_pk_bf16(f[0], f[1]); w.y = cvt_pk_bf16(f[2], f[3]); return w; }
__device__ __forceinline__ void cmul(float& r, float& i, float cr, float ci) { const float nr = r * cr - i * ci, ni = r * ci + i * cr; r = nr; i = ni; }
template <int R, int NS>
__device__ __forceinline__ void dft1_item(const Ctx& C, int seqtok0, int S, int unit0, int ch, int sb, int k10) {
    typedef typename VecN<NS>::T V;
    constexpr int NH = NS / 2;
    f32x2 a2[R][NH], b2[R][NH];
    {
        V pc[R], ps[R];
        const bf16_t* pcrow = C.PT + (size_t)ch * T_TOK + seqtok0 + NS * sb; const bf16_t* psrow = pcrow + (size_t)256 * T_TOK;
#pragma unroll
        for (int s1 = 0; s1 < R; ++s1) { pc[s1] = *(const V*)(pcrow + 256 * s1); ps[s1] = *(const V*)(psrow + 256 * s1); }
#pragma unroll
        for (int s1 = 0; s1 < R; ++s1) { float a[NS], b[NS]; unpackN(pc[s1], a); unpackN(ps[s1], b);
#pragma unroll
            for (int jj = 0; jj < NH; ++jj) { a2[s1][jj] = (f32x2){a[2 * jj], a[2 * jj + 1]}; b2[s1][jj] = (f32x2){b[2 * jj], b[2 * jj + 1]}; } }
    }
    const float scale = rsqrtf(64.0f * (float)S);
    float w1i, w1r, wki, wkr, m0i, m0r, twi, twr, e1i, e1r, sti, str_;
    sincospif(2.0f / (float)R, &w1i, &w1r); sincospif((float)k10 * (2.0f / (float)R), &wki, &wkr);
    const int s20 = NS * sb;
    sincospif((float)s20 * (2.0f / (float)S), &m0i, &m0r); sincospif((float)((k10 * s20) & (S - 1)) * (2.0f / (float)S), &twi, &twr); twi *= scale; twr *= scale;
    sincospif(2.0f / (float)S, &e1i, &e1r); sincospif((float)k10 * (2.0f / (float)S), &sti, &str_);
#pragma unroll 1
    for (int k1 = k10; k1 < k10 + 8; ++k1) {
        float wr = 1.f, wi = 0.f; f32x2 are[NH], aim[NH];
#pragma unroll
        for (int jj = 0; jj < NH; ++jj) { are[jj] = (f32x2){0.f, 0.f}; aim[jj] = (f32x2){0.f, 0.f}; }
#pragma unroll
        for (int s1 = 0; s1 < R; ++s1) {
#pragma unroll
            for (int jj = 0; jj < NH; ++jj) { are[jj] += a2[s1][jj] * wr - b2[s1][jj] * wi; aim[jj] += b2[s1][jj] * wr + a2[s1][jj] * wi; }
            cmul(wr, wi, wkr, wki);
        }
        float tc = twr, ts = twi, ore[NS], oim[NS];
#pragma unroll
        for (int jj = 0; jj < NH; ++jj) {
            ore[2 * jj] = are[jj].x * tc - aim[jj].x * ts; oim[2 * jj] = are[jj].x * ts + aim[jj].x * tc; cmul(tc, ts, str_, sti);
            ore[2 * jj + 1] = are[jj].y * tc - aim[jj].y * ts; oim[2 * jj + 1] = are[jj].y * ts + aim[jj].y * tc; cmul(tc, ts, str_, sti); }
        bf16_t* ob = C.APT + ((size_t)(unit0 + k1) * 256 + ch) * 512 + s20;
        *(V*)ob = packN(ore); *(V*)(ob + 256) = packN(oim);
        cmul(wkr, wki, w1r, w1i); cmul(twr, twi, m0r, m0i); cmul(str_, sti, e1r, e1i);
    }
}

__device__ __forceinline__ void p2_mixers_ab(const Ctx& C, int l, LAS unsigned char* lds, unsigned* cnt, unsigned nx) {
    const int G = gridDim.x, bid = blockIdx.x;
    if (opaque_tid() < 64) {
        unsigned sp = 0;
        while (__hip_atomic_load(cnt, __ATOMIC_RELAXED, __HIP_MEMORY_SCOPE_AGENT) < nx) { __builtin_amdgcn_s_sleep(2); if (++sp > (1u << 22)) break; }
        __builtin_amdgcn_fence(__ATOMIC_ACQUIRE, "agent");
        asm volatile("s_waitcnt vmcnt(0)" ::: "memory");
    }
    __syncthreads();
    mixer_a_units(C, l, lds);
    const int nlate = (2112 % G == 0) ? 0 : (2112 % G);
    const int vb = bid - nlate, NB = G - nlate;
    if (vb >= 0) { const int gt = vb * 512 + opaque_tid(), NGT = NB * 512; for (int it = gt; it < 1536 * 48; it += NGT) mixer_b_run(C, it); }
}
__device__ __forceinline__ void p2_dft1(const Ctx& C) {
    const int G = gridDim.x, bid = blockIdx.x, tid = opaque_tid();
    const int gt = bid * 512 + tid, NGT = G * 512;
    for (int it = gt; it < 131072; it += NGT) { const int sb = it & 63, ch = (it >> 6) & 255, kh = (it >> 14) & 1, b = it >> 15; dft1_item<16, 4>(C, TP + b * 4096, 4096, 128 + b * 16, ch, sb, 8 * kh); }
    for (int it = gt; it < 131072; it += NGT) { const int sb = it & 31, ch = (it >> 5) & 255, b = it >> 13; dft1_item<8, 8>(C, b * 2048, 2048, b * 8, ch, sb, 0); }
}

__device__ __forceinline__ void unpack8(const u32x4 p, float* f) { f[0] = bf_lo(p.x); f[1] = bf_hi(p.x); f[2] = bf_lo(p.y); f[3] = bf_hi(p.y); f[4] = bf_lo(p.z); f[5] = bf_hi(p.z); f[6] = bf_lo(p.w); f[7] = bf_hi(p.w); }
template <int L>
__device__ __forceinline__ void p5_residual(const Ctx& C) {
    const int tid = opaque_tid(), lane = tid & 63, wave = tid >> 6, G = gridDim.x, bid = blockIdx.x;
    const int gw = bid * 8 + wave, NGW = G * 8;
    const float* pg = C.post_g + L * 1024;
    f32x4 gv[2][2];
#pragma unroll
    for (int j = 0; j < 2; ++j) { gv[j][0] = *(const f32x4*)(pg + 8 * lane + 512 * j); gv[j][1] = *(const f32x4*)(pg + 8 * lane + 512 * j + 4); }
    for (int t2 = gw; t2 < T_TOK / 2; t2 += NGW) {
        const int t = 2 * t2;
        u32x4 yp[2][2]; float x[2][16];
#pragma unroll
        for (int r = 0; r < 2; ++r)
#pragma unroll
            for (int j = 0; j < 2; ++j) yp[r][j] = __builtin_nontemporal_load((const u32x4*)(C.YO + (size_t)(t + r) * 1024 + 8 * lane + 512 * j));
        {
            u32x4 xp[2][2]; float ri[2];
#pragma unroll
            for (int r = 0; r < 2; ++r) { ri[r] = C.RINV[t + r];
#pragma unroll
                for (int j = 0; j < 2; ++j) xp[r][j] = __builtin_nontemporal_load((const u32x4*)(C.XB + (size_t)(t + r) * 1024 + 8 * lane + 512 * j)); }
#pragma unroll
            for (int r = 0; r < 2; ++r)
#pragma unroll
                for (int j = 0; j < 2; ++j) { unpack8(xp[r][j], &x[r][8 * j]);
#pragma unroll
                    for (int i = 0; i < 8; ++i) x[r][8 * j + i] *= ri[r]; }
        }
        float y[2][16], ss[2];
#pragma unroll
        for (int r = 0; r < 2; ++r) { ss[r] = 0.f;
#pragma unroll
            for (int j = 0; j < 2; ++j) unpack8(yp[r][j], &y[r][8 * j]);
#pragma unroll
            for (int i = 0; i < 16; ++i) ss[r] += y[r][i] * y[r][i]; }
#pragma unroll
        for (int o = 1; o < 64; o <<= 1) { ss[0] += __shfl_xor(ss[0], o); ss[1] += __shfl_xor(ss[1], o); }
        float ss2[2];
#pragma unroll
        for (int r = 0; r < 2; ++r) { const float rr = rsqrtf(ss[r] * (1.0f / 1024.0f) + EPS); ss2[r] = 0.f;
#pragma unroll
            for (int j = 0; j < 2; ++j)
#pragma unroll
                for (int i = 0; i < 8; ++i) { const float gg = (i < 4) ? gv[j][0][i] : gv[j][1][i - 4]; const float o = x[r][8 * j + i] + y[r][8 * j + i] * rr * gg; x[r][8 * j + i] = o; ss2[r] += o * o; } }
        if (L == 0) {
#pragma unroll
            for (int o = 1; o < 64; o <<= 1) { ss2[0] += __shfl_xor(ss2[0], o); ss2[1] += __shfl_xor(ss2[1], o); }
#pragma unroll
            for (int r = 0; r < 2; ++r) { const float ms = ss2[r] * (1.0f / 1024.0f) + EPS; const float r2 = rsqrtf(ms);
                if (lane == 0) C.RINV[t + r] = ms * r2;
#pragma unroll
                for (int j = 0; j < 2; ++j) { u32x4 w; w.x = cvt_pk_bf16(x[r][8 * j + 0] * r2, x[r][8 * j + 1] * r2); w.y = cvt_pk_bf16(x[r][8 * j + 2] * r2, x[r][8 * j + 3] * r2);
                    w.z = cvt_pk_bf16(x[r][8 * j + 4] * r2, x[r][8 * j + 5] * r2); w.w = cvt_pk_bf16(x[r][8 * j + 6] * r2, x[r][8 * j + 7] * r2);
                    *(u32x4*)(C.XB + (size_t)(t + r) * 1024 + 8 * lane + 512 * j) = w; } }
        } else {
#pragma unroll
            for (int r = 0; r < 2; ++r) { float* orow = C.out + (size_t)(t + r) * 1024;
#pragma unroll
                for (int j = 0; j < 2; ++j) { *(f32x4*)(orow + 8 * lane + 512 * j) = (f32x4){x[r][8 * j + 0], x[r][8 * j + 1], x[r][8 * j + 2], x[r][8 * j + 3]};
                    *(f32x4*)(orow + 8 * lane + 512 * j + 4) = (f32x4){x[r][8 * j + 4], x[r][8 * j + 5], x[r][8 * j + 6], x[r][8 * j + 7]}; } }
        }
    }
}

#define XB_TMO      128
#define XB_XCNT(j)  (256  + 64 * (j))
#define XB_XSUB(j)  (1280 + 64 * (j))
#define XB_XGEN(j)  (2304 + 64 * (j))
#define XB_TOP      3328
#define XB_TOPGEN   3392
#define XCD_BAR_WORDS 3456
#define XB_SPIN_CAP (1u << 18)
__device__ __forceinline__ unsigned xb_ld(unsigned* p)              { return __hip_atomic_load(p, __ATOMIC_RELAXED, __HIP_MEMORY_SCOPE_AGENT); }
__device__ __forceinline__ unsigned xb_add(unsigned* p, unsigned v) { return __hip_atomic_fetch_add(p, v, __ATOMIC_RELAXED, __HIP_MEMORY_SCOPE_AGENT); }
__device__ __forceinline__ unsigned xb_xcc_id() { return (unsigned)__builtin_amdgcn_s_getreg((3 << 11) | 20) & 0xFu; }
#define XB_SPIN(cond, bar) do { unsigned _sp = 0; while (cond) { __builtin_amdgcn_s_sleep(1); \
    if ((++_sp & 255u) == 0u) { if (xb_ld(&(bar)[XB_TMO])) break; if (_sp > XB_SPIN_CAP) { atomicAdd(&(bar)[XB_TMO], 1u); break; } } } } while (0)
struct XcdBarrier { unsigned* bar; unsigned x; volatile LAS unsigned* st; };
__device__ __forceinline__ XcdBarrier xcd_barrier_post(unsigned* bar, volatile LAS unsigned* st) {
    XcdBarrier b; b.bar = bar; b.x = xb_xcc_id(); b.st = st;
    if (threadIdx.x == 0) (void)xb_add(&bar[XB_XCNT(b.x)], 1u);
    return b;
}
__device__ __forceinline__ void xcd_barrier_complete(unsigned* bar, unsigned x, unsigned& nloc, unsigned& nx) {
    const unsigned G = gridDim.x * gridDim.y * gridDim.z;
    unsigned sum, cnt, mine, sp = 0u;
    for (;;) {
        sum = 0u; cnt = 0u; mine = 0u;
#pragma unroll
        for (unsigned j = 0; j < 16; ++j) { const unsigned c = xb_ld(&bar[XB_XCNT(j)]); sum += c; cnt += (c > 0u) ? 1u : 0u; mine = (j == x) ? c : mine; }
        if (sum == G) break;
        __builtin_amdgcn_s_sleep(1);
        if ((++sp & 255u) == 0u) { if (xb_ld(&bar[XB_TMO])) break; if (sp > XB_SPIN_CAP) { atomicAdd(&bar[XB_TMO], 1u); break; } }
    }
    nloc = mine > 0u ? mine : 1u; nx = cnt > 0u ? cnt : 1u;
}
__device__ __forceinline__ void xcd_barrier(const XcdBarrier& b) {
    asm volatile("s_waitcnt vmcnt(0)" ::: "memory");
    __syncthreads();
    if (threadIdx.x == 0) {
        unsigned* bar = b.bar;
        __builtin_amdgcn_s_waitcnt(0);
        unsigned nloc = b.st[0], nx = b.st[1];
        if (nloc == 0u) { xcd_barrier_complete(bar, b.x, nloc, nx); b.st[0] = nloc; b.st[1] = nx; }
        const unsigned old = xb_add(&bar[XB_XSUB(b.x)], 1u);
        const unsigned gen = old / nloc;
        if (old + 1u == (gen + 1u) * nloc) {
            __builtin_amdgcn_fence(__ATOMIC_RELEASE, "agent");
            asm volatile("s_waitcnt vmcnt(0)" ::: "memory");
            const unsigned og = xb_add(&bar[XB_TOP], 1u);
            const unsigned tg = og / nx;
            if (og + 1u == (tg + 1u) * nx) xb_add(&bar[XB_TOPGEN], 1u);
            else XB_SPIN(xb_ld(&bar[XB_TOPGEN]) == tg, bar);
            __builtin_amdgcn_fence(__ATOMIC_ACQUIRE, "agent");
            xb_add(&bar[XB_XGEN(b.x)], 1u);
            asm volatile("s_waitcnt vmcnt(0)" ::: "memory");
        } else {
            XB_SPIN(xb_ld(&bar[XB_XGEN(b.x)]) == gen, bar);
            __builtin_amdgcn_fence(__ATOMIC_ACQUIRE, "agent");
            asm volatile("s_waitcnt vmcnt(0)" ::: "memory");
        }
    }
    __syncthreads();
}

__global__ void __launch_bounds__(512, 2) fwd_kernel(Args a) {
    extern __shared__ __attribute__((aligned(16))) unsigned char shm[];
    LAS unsigned char* lds = (LAS unsigned char*)shm;
    cg::grid_group grid = cg::this_grid();
    Ctx C;
    C.xp = a.in[0]; C.xs = a.in[1]; C.pre_g = a.in[2]; C.w_in = a.in[3]; C.a_ln_g = a.in[4]; C.a_ln_b = a.in[5]; C.a_w_s = a.in[6]; C.a_b_s = a.in[7];
    C.b_w = a.in[8]; C.b_scale = a.in[9]; C.c_w = a.in[10]; C.w_out = a.in[11]; C.post_g = a.in[12];
    C.out = a.out;
    C.W1T = (bf16_t*)(a.ws + OFF_W1T); C.WOT = (bf16_t*)(a.ws + OFF_WOT); C.WSB = (bf16_t*)(a.ws + OFF_WSB); C.DQ = (bf16_t*)(a.ws + OFF_DQ);
    C.XB = (bf16_t*)(a.ws + OFF_XB); C.APT = (bf16_t*)(a.ws + OFF_APT); C.RINV = (float*)(a.ws + OFF_RINV); C.PROJ = (bf16_t*)(a.ws + OFF_PROJ); C.PT = (bf16_t*)(a.ws + OFF_PT); C.YO = (bf16_t*)(a.ws + OFF_PROJ); C.YM = (bf16_t*)(a.ws + OFF_YM);
    const int G = gridDim.x, bid = blockIdx.x;
    volatile LAS unsigned* bst = (volatile LAS unsigned*)(lds + 131072);
    if (threadIdx.x < 4) bst[threadIdx.x] = 0u;
    __syncthreads();
    const XcdBarrier xbar = xcd_barrier_post((unsigned*)(a.ws + OFF_BAR), bst);
    for (int pi = a.ph_lo; pi < a.ph_hi; ++pi) {
        const int ph = (PROBE_REPEAT >= 0 && pi > PROBE_REPEAT) ? pi - 1 : pi;
        if (ph == 0) p0_prologue(C, lds);
        else {
            const int l = (ph - 1) / 5, sub = (ph - 1) % 5;
            if (sub == 0) { unsigned* cnt = (unsigned*)(a.ws + OFF_BAR) + 4096 + 2048 * l;     pg8::SchedG1 S; S.init(C.XB, C.W1T + (size_t)l * N1PAD * 1024, G, bid); S.cnt = cnt; S.x = xbar.x; S.nwav = 8u * bst[0]; S.xsub = cnt + 128; const unsigned nx = bst[1]; EpiProj E{C.PROJ, C.PT}; pg8::gemm_phase<GA, GS>(lds, 1024, S, E);
                p2_mixers_ab(C, l, lds, cnt, nx); }
            else if (sub == 1) p2_dft1(C);
            else if (sub == 2) { pg8::Gemm g{C.DQ, C.APT, 256, 192 * 256, 512}; pg8::SchedPlain S; S.init(g, G, bid); EpiDft E{C.PROJ, C.YM}; pg8::gemm_phase<false, GS, EpiDft, pg8::SchedPlain, true>(lds, 512, S, E); }
            else if (sub == 3) { pg8::Gemm g{C.YM, C.WOT + (size_t)l * 1024 * 1024, T_TOK, 1024, 1024}; pg8::SchedPlain S; S.init(g, G, bid); EpiY E{C.YO}; pg8::gemm_phase<GA, GS>(lds, 1024, S, E); }
            else { if (l == 0) p5_residual<0>(C); else p5_residual<1>(C); }
        }
        if (pi + 1 < a.ph_hi) { if (a.ph_hi > 1000) grid.sync();   xcd_barrier(xbar); }
    }
}

extern "C" void kernel_launch(void* const* d_in, const int* in_sizes, int n_in, void* d_out, int out_size, void* d_ws, size_t ws_size, hipStream_t stream) {
    static int grid = 0;
    if (grid == 0) {
        if (n_in != 13 || ws_size < WS_END) { fprintf(stderr, "kernel_launch: need 13 inputs and >= %zu bytes of workspace; got n_in %d, ws %zu\n", (size_t)WS_END, n_in, ws_size); grid = -1; return; }
        int dev = 0, cus = 0, per_cu = 0;
        hipGetDevice(&dev); hipDeviceGetAttribute(&cus, hipDeviceAttributeMultiprocessorCount, dev);
        if (hipFuncSetAttribute((const void*)fwd_kernel, hipFuncAttributeMaxDynamicSharedMemorySize, LDS_BYTES) != hipSuccess) { fprintf(stderr, "kernel_launch: hipFuncSetAttribute failed\n"); grid = -1; return; }
        if (hipOccupancyMaxActiveBlocksPerMultiprocessor(&per_cu, (const void*)fwd_kernel, 512, LDS_BYTES) != hipSuccess || per_cu < 1) { fprintf(stderr, "kernel_launch: occupancy query says %d\n", per_cu); per_cu = 1; }
        (void)hipGetLastError();
        grid = cus;
    }
    if (grid < 0) return;
    Args a{};
    for (int i = 0; i < 13; ++i) a.in[i] = (const float*)d_in[i];
    a.out = (float*)d_out; a.ws = (unsigned char*)d_ws;
    if (hipMemsetAsync((char*)d_ws + OFF_BAR, 0, 32768, stream) != hipSuccess) { fprintf(stderr, "kernel_launch: memset failed\n"); return; }
#if N_LAUNCH_MODE == 1
    a.ph_lo = 0; a.ph_hi = 11 + (PROBE_REPEAT >= 0 ? 1 : 0);
    void* args[] = {&a};
    hipError_t e = hipLaunchCooperativeKernel((const void*)fwd_kernel, dim3(grid), dim3(512), args, LDS_BYTES, stream);
    if (e != hipSuccess) fprintf(stderr, "cooperative launch failed: %s (grid %d)\n", hipGetErrorString(e), grid);
#else
    for (int ph = 0; ph < 11; ++ph) { a.ph_lo = ph; a.ph_hi = ph + 1; hipLaunchKernelGGL(fwd_kernel, dim3(grid), dim3(512), LDS_BYTES, stream, a); }
#endif
}
```
